# Optimizing an MI355X kernel written in HIP

```python
import jax, jax.numpy as jnp
from jax import lax
import numpy as np

D_MODEL = 1024
BATCH = 32
SEQ = 256
DEPTH = 2
DEC_BATCH = 8
DEC_SEQ = 1024
PAST_LEN = 256

GRID_W = 64
CHUNK = 128
A_GROUPS = 4
A_WIDTH = D_MODEL // 2
A_GROUP_DIM = A_WIDTH // A_GROUPS
B_GROUPS = 4
B_WIDTH = D_MODEL // 2
B_GROUP_DIM = B_WIDTH // B_GROUPS
HEAD_DIM = 128
N_HEADS = D_MODEL // HEAD_DIM
N_KV_HEADS = 2
KV_GROUP = N_HEADS // N_KV_HEADS
WINDOW = 128
Q_BLOCK = 128
BAND = Q_BLOCK + 2 * WINDOW
AXIS_DIM = HEAD_DIM // 2
ROPE_BASE = 10000.0
D_FF = ((8 * D_MODEL + 3 * 256 - 1) // (3 * 256)) * 256
N_EVEN = (DEPTH + 1) // 2
N_ODD = DEPTH // 2
EPS = 1e-6
NEG = -1e30

kernel_name = "hybrid_dit_gmlp_fnet_swa_step"


def rms_norm(x, g):
    xf = x.astype(jnp.float32)
    y = xf * lax.rsqrt(jnp.mean(xf * xf, axis=-1, keepdims=True) + EPS)
    return (y * g.astype(jnp.float32)).astype(x.dtype)


def layer_norm(x, g):
    xf = x.astype(jnp.float32)
    xc = xf - jnp.mean(xf, axis=-1, keepdims=True)
    y = xc * lax.rsqrt(jnp.mean(xc * xc, axis=-1, keepdims=True) + EPS)
    return (y * g.astype(jnp.float32)).astype(x.dtype)


def modulation(cond, w, b):
    m = jax.nn.silu(cond) @ w + b
    return [p[:, None, :] for p in jnp.split(m, 6, axis=-1)]


def modulate(h, shift, scale):
    return h * (1 + scale) + shift


def chunk_gmlp(u, v, sgu_w, sgu_b, sgu_g):
    bn, t, _ = v.shape
    v = layer_norm(v, sgu_g)
    vc = v.reshape(bn, t // CHUNK, CHUNK, A_GROUPS, A_GROUP_DIM)
    mixed = jnp.einsum('hpq,bnqhc->bnphc', sgu_w, vc) + sgu_b.T[None, None, :, :, None]
    return u * mixed.reshape(bn, t, A_WIDTH)


def fourier_mix(z):
    bn, t, _ = z.shape
    zg = z.reshape(bn, t, B_GROUPS, B_GROUP_DIM).astype(jnp.float32)
    f = jnp.fft.fft2(zg, axes=(1, 3), norm='ortho')
    return jnp.real(f).reshape(bn, t, B_WIDTH).astype(z.dtype)


def mixer_ab(h, w_in, sgu_w, sgu_b, sgu_g, w_out):
    z = h @ w_in
    u, v, zb = jnp.split(z, [A_WIDTH, 2 * A_WIDTH], axis=-1)
    a = chunk_gmlp(jax.nn.gelu(u), jax.nn.gelu(v), sgu_w, sgu_b, sgu_g)
    b = fourier_mix(zb)
    return jnp.concatenate([a, b], axis=-1) @ w_out


def qkv_proj(h, w_qkv):
    bn, t, _ = h.shape
    z = h @ w_qkv
    q, k, v = jnp.split(z, [N_HEADS * HEAD_DIM, (N_HEADS + N_KV_HEADS) * HEAD_DIM], axis=-1)
    return (q.reshape(bn, t, N_KV_HEADS, KV_GROUP, HEAD_DIM),
            k.reshape(bn, t, N_KV_HEADS, HEAD_DIM),
            v.reshape(bn, t, N_KV_HEADS, HEAD_DIM))


def axial_rope_tables(t):
    rows_n = t // GRID_W
    rows = jnp.repeat(jnp.arange(rows_n), GRID_W).astype(jnp.float32)
    cols = jnp.tile(jnp.arange(GRID_W), rows_n).astype(jnp.float32)
    inv = ROPE_BASE ** (-jnp.arange(0, AXIS_DIM, 2, dtype=jnp.float32) / AXIS_DIM)
    ar = rows[:, None] * inv
    ac = cols[:, None] * inv
    ang = jnp.concatenate([ar, ar, ac, ac], axis=-1)
    return jnp.cos(ang), jnp.sin(ang)


def apply_rope(x, cos, sin):
    xf = x.astype(jnp.float32)
    xs = xf.reshape(xf.shape[:-1] + (2, 2, AXIS_DIM // 2))
    rot = jnp.stack([-xs[..., 1, :], xs[..., 0, :]], axis=-2).reshape(xf.shape)
    bshape = (1, x.shape[1]) + (1,) * (x.ndim - 3) + (HEAD_DIM,)
    return (xf * cos.reshape(bshape) + rot * sin.reshape(bshape)).astype(x.dtype)


def sink_attend(q, ks, vs, masks, sink):
    scale = HEAD_DIM ** -0.5
    scores = []
    for k, m in zip(ks, masks):
        s = jnp.einsum('bqkgd,bskd->bkgqs', q, k).astype(jnp.float32) * scale
        if m is not None:
            s = jnp.where(m, s, NEG)
        scores.append(s)
    bn, nq = q.shape[0], q.shape[1]
    sink_col = jnp.broadcast_to(sink.astype(jnp.float32).reshape(1, N_KV_HEADS, KV_GROUP, 1, 1),
                                (bn, N_KV_HEADS, KV_GROUP, nq, 1))
    p = jax.nn.softmax(jnp.concatenate(scores + [sink_col], axis=-1), axis=-1)
    out = None
    off = 0
    for v in vs:
        n = v.shape[1]
        o = jnp.einsum('bkgqs,bskd->bqkgd', p[..., off:off + n].astype(v.dtype), v)
        out = o if out is None else out + o
        off += n
    return out


def split_query_blocks(q):
    bn, t = q.shape[:2]
    nb = t // Q_BLOCK
    return q.reshape(bn, nb, Q_BLOCK, N_KV_HEADS, KV_GROUP, HEAD_DIM).transpose(1, 0, 2, 3, 4, 5)


def merge_query_blocks(o, bn, t):
    return o.transpose(1, 0, 2, 3, 4, 5).reshape(bn, t, N_HEADS * HEAD_DIM)


def context_attention(q, k, v, sink):
    bn, s = q.shape[:2]
    out = lax.map(lambda qi: sink_attend(qi, [k], [v], [None], sink), split_query_blocks(q))
    return merge_query_blocks(out, bn, s)


def latent_attention(q, k, v, ck, cv, sink):
    bn, t = q.shape[:2]
    nb = t // Q_BLOCK
    pad = ((0, 0), (WINDOW, WINDOW), (0, 0), (0, 0))
    kp = jnp.pad(k, pad)
    vp = jnp.pad(v, pad)

    def block(args):
        qi, j = args
        start = j * Q_BLOCK
        kb = lax.dynamic_slice_in_dim(kp, start, BAND, axis=1)
        vb = lax.dynamic_slice_in_dim(vp, start, BAND, axis=1)
        qpos = start + jnp.arange(Q_BLOCK)
        kpos = start - WINDOW + jnp.arange(BAND)
        mask = ((kpos >= 0) & (kpos < t))[None, :] & (jnp.abs(qpos[:, None] - kpos[None, :]) <= WINDOW)
        return sink_attend(qi, [kb, ck], [vb, cv], [mask, None], sink)

    out = lax.map(block, (split_query_blocks(q), jnp.arange(nb)))
    return merge_query_blocks(out, bn, t)


def swiglu(h, w_gate, w_up, w_down):
    return (jax.nn.silu(h @ w_gate) * (h @ w_up)) @ w_down


def _normal(k, shape, scale):
    return jax.random.normal(k, shape, jnp.float32) * scale


def setup_inputs(seed: int = 0) -> dict:
    key = jax.random.key(seed)
    ks = jax.random.split(key, 24)
    d = D_MODEL
    qkv_w = (N_HEADS + 2 * N_KV_HEADS) * HEAD_DIM
    return {
        'x_prompt': _normal(ks[0], (BATCH, SEQ, d), 1.0),
        'x_sample': _normal(ks[1], (DEC_BATCH, DEC_SEQ, d), 1.0),
        'cache_k': _normal(ks[2], (DEC_BATCH, N_ODD, PAST_LEN, N_KV_HEADS, HEAD_DIM), 1.0),
        'cache_v': _normal(ks[3], (DEC_BATCH, N_ODD, PAST_LEN, N_KV_HEADS, HEAD_DIM), 1.0),
        'c': _normal(ks[4], (DEC_BATCH, d), 1.0),
        'c_ctx': _normal(ks[5], (d,), 1.0),
        'mod_w': _normal(ks[6], (DEPTH, d, 6 * d), 0.5 * d ** -0.5),
        'mod_b': _normal(ks[7], (DEPTH, 6 * d), 0.02),
        'norm_pre_mix': 1.0 + _normal(ks[8], (DEPTH, d), 0.02),
        'norm_post_mix': 1.0 + _normal(ks[9], (DEPTH, d), 0.02),
        'norm_pre_ffn': 1.0 + _normal(ks[10], (DEPTH, d), 0.02),
        'norm_post_ffn': 1.0 + _normal(ks[11], (DEPTH, d), 0.02),
        'ab_w_in': _normal(ks[12], (N_EVEN, d, 2 * A_WIDTH + B_WIDTH), d ** -0.5),
        'sgu_w': _normal(ks[13], (N_EVEN, A_GROUPS, CHUNK, CHUNK), CHUNK ** -0.5),
        'sgu_b': 1.0 + _normal(ks[14], (N_EVEN, A_GROUPS, CHUNK), 0.02),
        'sgu_g': 1.0 + _normal(ks[15], (N_EVEN, A_WIDTH), 0.02),
        'ab_w_out': _normal(ks[16], (N_EVEN, A_WIDTH + B_WIDTH, d), (A_WIDTH + B_WIDTH) ** -0.5),
        'attn_w_qkv': _normal(ks[17], (N_ODD, d, qkv_w), d ** -0.5),
        'attn_sink': _normal(ks[18], (N_ODD, N_HEADS), 0.5),
        'attn_w_o': _normal(ks[19], (N_ODD, N_HEADS * HEAD_DIM, d), (N_HEADS * HEAD_DIM) ** -0.5),
        'ffn_w_gate': _normal(ks[20], (DEPTH, d, D_FF), d ** -0.5),
        'ffn_w_up': _normal(ks[21], (DEPTH, d, D_FF), d ** -0.5),
        'ffn_w_down': _normal(ks[22], (DEPTH, D_FF, d), D_FF ** -0.5),
    }


def reference(x_prompt, x_sample, cache_k, cache_v, c, c_ctx, mod_w, mod_b,
              norm_pre_mix, norm_post_mix, norm_pre_ffn, norm_post_ffn,
              ab_w_in, sgu_w, sgu_b, sgu_g, ab_w_out,
              attn_w_qkv, attn_sink, attn_w_o,
              ffn_w_gate, ffn_w_up, ffn_w_down):
    t = x_sample.shape[1]
    cos, sin = axial_rope_tables(t)
    xp, xs = x_prompt, x_sample
    new_k, new_v = [], []
    for layer in range(DEPTH):
        mp = modulation(c_ctx[None, :], mod_w[layer], mod_b[layer])
        msm = modulation(c, mod_w[layer], mod_b[layer])
        hp = modulate(rms_norm(xp, norm_pre_mix[layer]), mp[0], mp[1])
        hs = modulate(rms_norm(xs, norm_pre_mix[layer]), msm[0], msm[1])
        if layer % 2 == 0:
            e = layer // 2
            op = mixer_ab(hp, ab_w_in[e], sgu_w[e], sgu_b[e], sgu_g[e], ab_w_out[e])
            osm = mixer_ab(hs, ab_w_in[e], sgu_w[e], sgu_b[e], sgu_g[e], ab_w_out[e])
        else:
            o = layer // 2
            qp, kp, vp = qkv_proj(hp, attn_w_qkv[o])
            new_k.append(kp)
            new_v.append(vp)
            op = context_attention(qp, kp, vp, attn_sink[o]) @ attn_w_o[o]
            qs, kl, vl = qkv_proj(hs, attn_w_qkv[o])
            qs = apply_rope(qs, cos, sin)
            kl = apply_rope(kl, cos, sin)
            osm = latent_attention(qs, kl, vl, cache_k[:, o], cache_v[:, o], attn_sink[o]) @ attn_w_o[o]
        xp = xp + mp[2] * rms_norm(op, norm_post_mix[layer])
        xs = xs + msm[2] * rms_norm(osm, norm_post_mix[layer])
        hp = modulate(rms_norm(xp, norm_pre_ffn[layer]), mp[3], mp[4])
        hs = modulate(rms_norm(xs, norm_pre_ffn[layer]), msm[3], msm[4])
        fp = swiglu(hp, ffn_w_gate[layer], ffn_w_up[layer], ffn_w_down[layer])
        fs = swiglu(hs, ffn_w_gate[layer], ffn_w_up[layer], ffn_w_down[layer])
        xp = xp + mp[5] * rms_norm(fp, norm_post_ffn[layer])
        xs = xs + msm[5] * rms_norm(fs, norm_post_ffn[layer])
    state_k = jnp.stack(new_k, axis=1)
    state_v = jnp.stack(new_v, axis=1)
    return (xp, xs, state_k, state_v)
```

```cpp
#include <hip/hip_runtime.h>
#include <hip/hip_cooperative_groups.h>
#include <cstdio>
#include <cstdint>
namespace cg = cooperative_groups;

#ifndef MK_PER_PHASE
#define MK_PER_PHASE 0
#endif

#define LAS __attribute__((address_space(3)))
typedef unsigned short bf16_t;
typedef short bf16x8 __attribute__((ext_vector_type(8)));
typedef short bf16x4 __attribute__((ext_vector_type(4)));
typedef float f32x4 __attribute__((ext_vector_type(4)));
typedef unsigned u32x4 __attribute__((ext_vector_type(4)));
typedef unsigned u32x2 __attribute__((ext_vector_type(2)));

constexpr int NTOK = 16384, NP = 8192, D = 1024, DFF = 2816;
constexpr float EPS = 1e-6f;
constexpr float LOG2E = 1.4426950408889634f;
constexpr float QSCALE = 0.08838834764831845f * LOG2E;

constexpr size_t MiB = 1024 * 1024;
constexpr size_t WS_MOD = 0;
constexpr size_t WS_STATS = 512 * 1024;
constexpr size_t WS_BAR = 896 * 1024;
constexpr size_t WS_SLOTS = 236 * MiB;
constexpr size_t WS_CK = 1 * MiB;
constexpr size_t WS_CVT = 2 * MiB;
constexpr size_t WS_CS256 = 3 * MiB;
constexpr size_t WS_ROPE = 3 * MiB + 512 * 1024;
constexpr size_t WS_CS1024 = 4 * MiB;
constexpr size_t WS_WIN = 8 * MiB;
constexpr size_t WS_WOUT = 12 * MiB;
constexpr size_t WS_WQKV = 14 * MiB;
constexpr size_t WS_WO = 17 * MiB;
constexpr size_t WS_WGU = 19 * MiB;
constexpr size_t WS_WDN = 41 * MiB;
constexpr size_t WS_H = 52 * MiB;
constexpr size_t WS_R2 = WS_H;
constexpr size_t WS_X = 84 * MiB;
constexpr size_t WS_R3 = 116 * MiB;
constexpr size_t WS_R1 = 148 * MiB;
constexpr size_t WS_END = 256 * MiB;
constexpr size_t R1_U = 0, R1_VT0 = 16 * MiB, R1_PQT = 32 * MiB;
constexpr size_t WS_Q = WS_R3, WS_K1 = 240 * MiB, WS_VT1 = 248 * MiB;

constexpr int LDS_BYTES = 132 * 1024;
constexpr int NPHASE = 16;

__device__ __forceinline__ unsigned cvt_pk_bf16(float lo, float hi) { unsigned r; asm volatile("v_cvt_pk_bf16_f32 %0, %1, %2" : "=v"(r) : "v"(lo), "v"(hi)); return r; }
__device__ __forceinline__ float bf_lo(unsigned w) { return __uint_as_float(w << 16); }
__device__ __forceinline__ float bf_hi(unsigned w) { return __uint_as_float(w & 0xffff0000u); }
__device__ __forceinline__ float fast_rcp(float x) { return __builtin_amdgcn_rcpf(x); }
__device__ __forceinline__ float fast_exp2(float x) { return __builtin_amdgcn_exp2f(x); }
__device__ __forceinline__ float silu_f(float x) { return x * fast_rcp(1.0f + fast_exp2(-x * LOG2E)); }
__device__ __forceinline__ float gelu_f(float x) { const float y = 0.7978845608028654f * (x + 0.044715f * x * x * x); return x * fast_rcp(1.0f + fast_exp2(-2.0f * LOG2E * y)); }
__device__ __forceinline__ float wave_sum(float v) {
    v += __shfl_xor(v, 1); v += __shfl_xor(v, 2); v += __shfl_xor(v, 4); v += __shfl_xor(v, 8); v += __shfl_xor(v, 16); v += __shfl_xor(v, 32); return v;
}


#define XB_TMO      128
#define XB_KVCNT    68
#define XB_TRCNT    66
#define XB_XCNT(j)  (256  + 64 * (j))
#define XB_XSUB(j)  (1280 + 64 * (j))
#define XB_XGEN(j)  (2304 + 64 * (j))
#define XB_TOP      3328
#define XB_TOPGEN   3392
#define XCD_BAR_WORDS 3456
#define XB_SPIN_CAP (1u << 20)
__device__ __forceinline__ unsigned xb_ld(unsigned* p)              { return __hip_atomic_load(p, __ATOMIC_RELAXED, __HIP_MEMORY_SCOPE_AGENT); }
__device__ __forceinline__ unsigned xb_add(unsigned* p, unsigned v) { return __hip_atomic_fetch_add(p, v, __ATOMIC_RELAXED, __HIP_MEMORY_SCOPE_AGENT); }
__device__ __forceinline__ unsigned xb_xcc_id() { return (unsigned)__builtin_amdgcn_s_getreg((3 << 11) | 20) & 0xFu; }
#define XB_SPIN(cond, bar) do { unsigned _sp = 0; while (cond) { __builtin_amdgcn_s_sleep(1); \
    if ((++_sp & 255u) == 0u) { if (xb_ld(&(bar)[XB_TMO])) break; if (_sp > XB_SPIN_CAP) { atomicAdd(&(bar)[XB_TMO], 1u); break; } } } } while (0)
struct XcdBarrier { unsigned* bar; unsigned x; volatile LAS unsigned* st; };
__device__ __forceinline__ XcdBarrier xcd_barrier_post(unsigned* bar, volatile LAS unsigned* st) {
    XcdBarrier b; b.bar = bar; b.x = xb_xcc_id(); b.st = st;
    if (threadIdx.x == 0) (void)xb_add(&bar[XB_XCNT(b.x)], 1u);
    return b;
}
__device__ __forceinline__ void xcd_barrier_complete(unsigned* bar, unsigned x, unsigned& nloc, unsigned& nx) {
    const unsigned G = gridDim.x * gridDim.y * gridDim.z;
    unsigned sum, cnt, mine, sp = 0u;
    for (;;) {
        sum = 0u; cnt = 0u; mine = 0u;
#pragma unroll
        for (unsigned j = 0; j < 16; ++j) { const unsigned c = xb_ld(&bar[XB_XCNT(j)]); sum += c; cnt += (c > 0u) ? 1u : 0u; mine = (j == x) ? c : mine; }
        if (sum == G) break;
        __builtin_amdgcn_s_sleep(1);
        if ((++sp & 255u) == 0u) { if (xb_ld(&bar[XB_TMO])) break; if (sp > XB_SPIN_CAP) { atomicAdd(&bar[XB_TMO], 1u); break; } }
    }
    nloc = mine > 0u ? mine : 1u; nx = cnt > 0u ? cnt : 1u;
}
__device__ __forceinline__ void xcd_barrier(const XcdBarrier& b) {
    asm volatile("s_waitcnt vmcnt(0)" ::: "memory");
    __syncthreads();
    if (threadIdx.x == 0) {
        unsigned* bar = b.bar;
        __builtin_amdgcn_s_waitcnt(0);
        unsigned nloc = b.st[0], nx = b.st[1];
        if (nloc == 0u) { xcd_barrier_complete(bar, b.x, nloc, nx); b.st[0] = nloc; b.st[1] = nx; }
        const unsigned old = xb_add(&bar[XB_XSUB(b.x)], 1u);
        const unsigned gen = old / nloc;
        if (old + 1u == (gen + 1u) * nloc) {
            __builtin_amdgcn_fence(__ATOMIC_RELEASE, "agent");
            asm volatile("s_waitcnt vmcnt(0)" ::: "memory");
            const unsigned og = xb_add(&bar[XB_TOP], 1u);
            const unsigned tg = og / nx;
            if (og + 1u == (tg + 1u) * nx) xb_add(&bar[XB_TOPGEN], 1u);
            else XB_SPIN(xb_ld(&bar[XB_TOPGEN]) == tg, bar);
            __builtin_amdgcn_fence(__ATOMIC_ACQUIRE, "agent");
            xb_add(&bar[XB_XGEN(b.x)], 1u);
            asm volatile("s_waitcnt vmcnt(0)" ::: "memory");
        } else {
            XB_SPIN(xb_ld(&bar[XB_XGEN(b.x)]) == gen, bar);
            __builtin_amdgcn_fence(__ATOMIC_ACQUIRE, "agent");
            asm volatile("s_waitcnt vmcnt(0)" ::: "memory");
        }
    }
    __syncthreads();
}

__device__ __forceinline__ void grp_sync(unsigned* w, unsigned* bar, const unsigned need = 4u) {
    asm volatile("s_waitcnt vmcnt(0)" ::: "memory");
    __syncthreads();
    if (threadIdx.x == 0) {
        const unsigned x = xb_xcc_id();
        unsigned long long* aw = (unsigned long long*)w;
        unsigned long long v = __hip_atomic_fetch_add(aw, 1ull << (4u * x), __ATOMIC_RELAXED, __HIP_MEMORY_SCOPE_AGENT) + (1ull << (4u * x));
        unsigned sum; unsigned sp = 0u;
        for (;;) { sum = 0u;
#pragma unroll
            for (int j = 0; j < 16; ++j) sum += (unsigned)(v >> (4 * j)) & 15u;
            if (sum >= need) break;
            __builtin_amdgcn_s_sleep(1);
            v = __hip_atomic_load(aw, __ATOMIC_RELAXED, __HIP_MEMORY_SCOPE_AGENT);
            if ((++sp & 255u) == 0u) { if (xb_ld(&bar[XB_TMO])) break; if (sp > XB_SPIN_CAP) { atomicAdd(&bar[XB_TMO], 1u); break; } } }
        if (((unsigned)(v >> (4u * x)) & 15u) != need) {
            __builtin_amdgcn_fence(__ATOMIC_RELEASE, "agent");
            asm volatile("s_waitcnt vmcnt(0)" ::: "memory");
            (void)xb_add(w + 2, 1u); XB_SPIN(xb_ld(w + 2) < need, bar); }
        __builtin_amdgcn_fence(__ATOMIC_ACQUIRE, "agent");
        asm volatile("s_waitcnt vmcnt(0)" ::: "memory");
    }
    __syncthreads();
}

namespace pg8 {
constexpr int BM = 256, BK = 64, HALF = 128, HTB = HALF * BK * 2, STAGE_BYTES = 8 * HTB;
__host__ __device__ __forceinline__ int lds_byte(int r, int c) { const int st = (r >> 4) * 2 + (c >> 5), rr = r & 15, cc = c & 31, ob = rr * 64 + cc * 2; return st * 1024 + (ob ^ (((ob >> 9) & 1) << 5)); }
__host__ __device__ __forceinline__ void stage_rc(int b, int& R, int& C) { const int st = b / 1024, sb = b % 1024, swz = sb ^ (((sb >> 9) & 1) << 5); R = (st >> 1) * 16 + swz / 64; C = (st & 1) * 32 + (swz % 64) / 2; }
__host__ __device__ __forceinline__ int perm32(int rho) { const int n = rho >> 4, i = rho & 15; return 8 * (i >> 2) + 4 * n + (i & 3); }

struct Unit { int pm, pn, kind, pad; const char* a; const char* b; };

template <class Epi, class Sched>
__device__ __forceinline__ void gemm_phase(LAS unsigned char* lds, const int K, const Sched& S, const Epi& E, const int pitch_ = 0) {
    const int tid = threadIdx.x, wid = __builtin_amdgcn_readfirstlane(tid >> 6), lane = tid & 63, wr = wid >> 2, wc = wid & 3, fr = lane & 15, fq = lane >> 4;
    const int nt = K / BK, pitch = pitch_ ? pitch_ : K;
    unsigned voffA[2], voffB[2];
#pragma unroll
    for (int i = 0; i < 2; ++i) { int R, C; stage_rc(tid * 16 + i * 8192, R, C); const int Rb = Epi::PERM ? ((R & ~31) + perm32(R & 31)) : R;
        voffA[i] = (unsigned)(R * pitch + C) * 2u; voffB[i] = (unsigned)(Rb * pitch + C) * 2u; }
    const size_t kstep = (size_t)(BK * 2);
    const size_t hstep = (size_t)HALF * pitch * 2;
    const unsigned ldsw = (unsigned)wid * 1024u;
    const int aoff = lds_byte(wr * 64 + fr, fq * 8), boff = lds_byte(wc * 32 + fr, fq * 8);
#define PG8_SA(b, h) (((b) * 2 + (h)) * HTB)
#define PG8_SB(b, h) ((4 + (b) * 2 + (h)) * HTB)
#define PG8_STAGE(bufoff, gbase, voff) do { _Pragma("unroll") for (int _i = 0; _i < 2; ++_i) \
        __builtin_amdgcn_global_load_lds((const unsigned*)((const char*)(gbase) + (voff)[_i]), (LAS unsigned*)(lds + (bufoff) + ldsw + _i * 8192), 16, 0, 0); } while (0)
#define PG8_LDA(dst, b, h) do { _Pragma("unroll") for (int m = 0; m < 4; ++m) _Pragma("unroll") for (int k = 0; k < 2; ++k) dst[m][k] = *(const LAS bf16x8*)(lds + PG8_SA(b, h) + aoff + m * 2048 + k * 1024); } while (0)
#define PG8_LDB(dst, b, h) do { _Pragma("unroll") for (int n = 0; n < 2; ++n) _Pragma("unroll") for (int k = 0; k < 2; ++k) dst[n][k] = *(const LAS bf16x8*)(lds + PG8_SB(b, h) + boff + n * 2048 + k * 1024); } while (0)
#define PG8_MMA(ai, bj, At, Bt) do { __builtin_amdgcn_s_setprio(1); _Pragma("unroll") for (int m = 0; m < 4; ++m) _Pragma("unroll") for (int n = 0; n < 2; ++n) _Pragma("unroll") for (int k = 0; k < 2; ++k) \
        acc[ai][bj][m][n] = __builtin_amdgcn_mfma_f32_16x16x32_bf16(Bt[n][k], At[m][k], acc[ai][bj][m][n], 0, 0, 0); __builtin_amdgcn_s_setprio(0); } while (0)
#define PG8_WAIT_V(n) asm volatile("s_waitcnt vmcnt(" #n ")" ::: "memory")
#define PG8_WAIT_L(n) asm volatile("s_waitcnt lgkmcnt(" #n ")" ::: "memory")
#define PG8_BAR __builtin_amdgcn_s_barrier()
#define PG8_SCHED __builtin_amdgcn_sched_barrier(0)
    Unit cur, nxt; int ui = 0;
    if (!S.next(0, cur)) return;
    f32x4 acc[2][2][4][2];
#pragma unroll
    for (int a = 0; a < 2; ++a)
#pragma unroll
        for (int b = 0; b < 2; ++b)
#pragma unroll
            for (int m = 0; m < 4; ++m)
#pragma unroll
                for (int n = 0; n < 2; ++n) acc[a][b][m][n] = (f32x4){0.f, 0.f, 0.f, 0.f};
    bf16x8 At[4][2], B0[2][2], B1[2][2];
    const char* cA = cur.a; const char* cB = cur.b;
    PG8_STAGE(PG8_SB(0, 0), cB, voffB); PG8_STAGE(PG8_SB(0, 1), cB + hstep, voffB); PG8_STAGE(PG8_SA(0, 0), cA, voffA); PG8_STAGE(PG8_SA(0, 1), cA + hstep, voffA);
    if (wr == 1) PG8_BAR;
    PG8_WAIT_V(2); PG8_BAR;
    PG8_STAGE(PG8_SB(1, 0), cB + kstep, voffB); PG8_STAGE(PG8_SA(1, 0), cA + kstep, voffA); PG8_STAGE(PG8_SB(1, 1), cB + hstep + kstep, voffB);
    PG8_WAIT_V(6); PG8_BAR;
    for (;;) {
        const bool has_next = S.next(ui + 1, nxt);
        const char* nA = has_next ? nxt.a : cA; const char* nB = has_next ? nxt.b : cB;
        for (int t = 0; t < nt; t += 2) {
            const bool last = (t == nt - 2);
            const char* a1 = cA + (size_t)(t + 1) * kstep;
            const char* a2 = last ? nA : cA + (size_t)(t + 2) * kstep; const char* b2 = last ? nB : cB + (size_t)(t + 2) * kstep;
            const char* a3 = a2 + kstep; const char* b3 = b2 + kstep;
            PG8_LDB(B0, 0, 0); PG8_LDB(B1, 0, 1); PG8_SCHED; PG8_LDA(At, 0, 0); PG8_STAGE(PG8_SA(1, 1), a1 + hstep, voffA);
            PG8_WAIT_V(8); PG8_WAIT_L(0); PG8_BAR; PG8_MMA(0, 0, At, B0); PG8_MMA(0, 1, At, B1); PG8_BAR; PG8_SCHED;
            PG8_LDA(At, 0, 1); PG8_STAGE(PG8_SB(0, 0), b2, voffB); PG8_STAGE(PG8_SB(0, 1), b2 + hstep, voffB); PG8_STAGE(PG8_SA(0, 0), a2, voffA);
            PG8_WAIT_V(8); PG8_WAIT_L(0); PG8_BAR; PG8_MMA(1, 0, At, B0); PG8_MMA(1, 1, At, B1); PG8_BAR; PG8_SCHED;
            PG8_LDB(B0, 1, 0); PG8_LDB(B1, 1, 1); PG8_SCHED; PG8_LDA(At, 1, 0); PG8_STAGE(PG8_SA(0, 1), a2 + hstep, voffA);
            PG8_WAIT_V(8); PG8_WAIT_L(0); PG8_BAR; PG8_MMA(0, 0, At, B0); PG8_MMA(0, 1, At, B1); PG8_BAR; PG8_SCHED;
            PG8_LDA(At, 1, 1); PG8_STAGE(PG8_SB(1, 0), b3, voffB); PG8_STAGE(PG8_SB(1, 1), b3 + hstep, voffB); PG8_STAGE(PG8_SA(1, 0), a3, voffA);
            PG8_WAIT_V(8); PG8_WAIT_L(0); PG8_BAR; PG8_MMA(1, 0, At, B0); PG8_MMA(1, 1, At, B1); PG8_BAR; PG8_SCHED;
        }
        if (wr == 0) PG8_BAR;
        { int efr = fr, efq = fq; asm volatile("" : "+v"(efr), "+v"(efq));
          if constexpr (!Epi::AFTER_DRAIN) E(acc, cur, wr, wc, efr, efq); }
        if (!has_next) break;
#pragma unroll
        for (int a = 0; a < 2; ++a)
#pragma unroll
            for (int b = 0; b < 2; ++b)
#pragma unroll
                for (int m = 0; m < 4; ++m)
#pragma unroll
                    for (int n = 0; n < 2; ++n) acc[a][b][m][n] = (f32x4){0.f, 0.f, 0.f, 0.f};
        cur = nxt; cA = nA; cB = nB; ++ui;
        if (wr == 1) PG8_BAR;
    }
    PG8_WAIT_V(0);
    PG8_BAR;
    if constexpr (Epi::AFTER_DRAIN) { int efr = fr, efq = fq; asm volatile("" : "+v"(efr), "+v"(efq)); E.fused(acc, cur, wr, wc, efr, efq, lds, wid, lane); }
#undef PG8_SA
#undef PG8_SB
#undef PG8_STAGE
#undef PG8_LDA
#undef PG8_LDB
#undef PG8_MMA
#undef PG8_WAIT_V
#undef PG8_WAIT_L
#undef PG8_BAR
#undef PG8_SCHED
}
}
using pg8::Unit;
typedef f32x4 Acc[2][2][4][2];

__device__ __forceinline__ u32x4 pack8(const f32x4 v0, const f32x4 v1) { u32x4 w; w.x = cvt_pk_bf16(v0[0], v0[1]); w.y = cvt_pk_bf16(v0[2], v0[3]); w.z = cvt_pk_bf16(v1[0], v1[1]); w.w = cvt_pk_bf16(v1[2], v1[3]); return w; }

struct EpiL0 {
    static constexpr bool PERM = true, AFTER_DRAIN = false;
    bf16_t* U; bf16_t* VT; bf16_t* PQT;
    __device__ __forceinline__ void operator()(Acc& acc, const Unit& u, int wr, int wc, int fr, int fq) const {
        if (u.kind == 0) {
            const int row0 = u.pm * 256 + wr * 64 + fr, col0 = u.pn * 256 + wc * 32 + 8 * fq;
#pragma unroll
            for (int ai = 0; ai < 2; ++ai)
#pragma unroll
                for (int m = 0; m < 4; ++m) { bf16_t* rowp = U + (size_t)(row0 + ai * 128 + m * 16) * 512 + col0;
#pragma unroll
                    for (int bj = 0; bj < 2; ++bj) { f32x4 v0 = acc[ai][bj][m][0], v1 = acc[ai][bj][m][1];
#pragma unroll
                        for (int e = 0; e < 4; ++e) { v0[e] = gelu_f(v0[e]); v1[e] = gelu_f(v1[e]); }
                        *(u32x4*)(rowp + bj * 128) = pack8(v0, v1); } }
        } else if (u.pm < 2) {
            const int ch0 = u.pm * 256 + wr * 64 + fr, tok0 = u.pn * 256 + wc * 32 + 8 * fq;
#pragma unroll
            for (int ai = 0; ai < 2; ++ai)
#pragma unroll
                for (int m = 0; m < 4; ++m) { bf16_t* rowp = VT + (size_t)(ch0 + ai * 128 + m * 16) * NTOK + tok0;
#pragma unroll
                    for (int bj = 0; bj < 2; ++bj) {
#pragma unroll
                        for (int e = 0; e < 4; ++e) { acc[ai][bj][m][0][e] = gelu_f(acc[ai][bj][m][0][e]); acc[ai][bj][m][1][e] = gelu_f(acc[ai][bj][m][1][e]); }
                        *(u32x4*)(rowp + bj * 128) = pack8(acc[ai][bj][m][0], acc[ai][bj][m][1]); } }
        } else {
            const int chq = (u.pm - 2) * 256 + wr * 64 + fr;
            size_t base; int T, t0;
            if (u.pn < 32) { base = (size_t)u.pn * 262144; T = 256; t0 = 0; } else { base = (size_t)8388608 + (size_t)((u.pn - 32) >> 2) * 1048576; T = 1024; t0 = ((u.pn - 32) & 3) * 256; }
            const int tl = t0 + wc * 32 + 8 * fq;
#pragma unroll
            for (int ai = 0; ai < 2; ++ai)
#pragma unroll
                for (int m = 0; m < 4; ++m) { const int cq = chq + ai * 128 + m * 16, isq = cq >> 9, ch = cq & 511;
                    bf16_t* rowp = PQT + base + (size_t)ch * (2 * T) + isq * T + tl;
#pragma unroll
                    for (int bj = 0; bj < 2; ++bj) *(u32x4*)(rowp + bj * 128) = pack8(acc[ai][bj][m][0], acc[ai][bj][m][1]); }
        }
    }
};

struct EpiPlain {
    static constexpr bool PERM = true, AFTER_DRAIN = false;
    bf16_t* O; int ldc, coff;
    __device__ __forceinline__ void operator()(Acc& acc, const Unit& u, int wr, int wc, int fr, int fq) const {
        const int row0 = u.pm * 256 + wr * 64 + fr, col0 = coff + u.pn * 256 + wc * 32 + 8 * fq;
#pragma unroll
        for (int ai = 0; ai < 2; ++ai)
#pragma unroll
            for (int m = 0; m < 4; ++m) { bf16_t* rowp = O + (size_t)(row0 + ai * 128 + m * 16) * ldc + col0;
#pragma unroll
                for (int bj = 0; bj < 2; ++bj) *(u32x4*)(rowp + bj * 128) = pack8(acc[ai][bj][m][0], acc[ai][bj][m][1]); }
    }
};

struct EpiOutSS {
    static constexpr bool PERM = true, AFTER_DRAIN = false;
    bf16_t* O; float* rowss;
    __device__ __forceinline__ void operator()(Acc& acc, const Unit& u, int wr, int wc, int fr, int fq) const {
        const int row0 = u.pm * 256 + wr * 64 + fr, col0 = u.pn * 256 + wc * 32 + 8 * fq;
#pragma unroll
        for (int ai = 0; ai < 2; ++ai)
#pragma unroll
            for (int m = 0; m < 4; ++m) { const int row = row0 + ai * 128 + m * 16; bf16_t* rowp = O + (size_t)row * D + col0; float ss = 0.f;
#pragma unroll
                for (int bj = 0; bj < 2; ++bj) { const f32x4 v0 = acc[ai][bj][m][0], v1 = acc[ai][bj][m][1];
                    ss += (v0[0] * v0[0] + v0[1] * v0[1]) + (v0[2] * v0[2] + v0[3] * v0[3]) + (v1[0] * v1[0] + v1[1] * v1[1]) + (v1[2] * v1[2] + v1[3] * v1[3]);
                    *(u32x4*)(rowp + bj * 128) = pack8(v0, v1); }
                ss += __shfl_xor(ss, 16); ss += __shfl_xor(ss, 32);
                if (fq == 0) atomicAdd(rowss + row, ss); }
    }
};

struct EpiSwiGLU {
    static constexpr bool PERM = true, AFTER_DRAIN = false;
    bf16_t* HF;
    __device__ __forceinline__ void operator()(Acc& acc, const Unit& u, int wr, int wc, int fr, int fq) const {
        const int row0 = u.pm * 256 + wr * 64 + fr, col0 = u.pn * 128 + wc * 32 + 8 * fq;
#pragma unroll
        for (int ai = 0; ai < 2; ++ai)
#pragma unroll
            for (int m = 0; m < 4; ++m) { bf16_t* rowp = HF + (size_t)(row0 + ai * 128 + m * 16) * DFF + col0;
                f32x4 v0, v1;
#pragma unroll
                for (int e = 0; e < 4; ++e) { v0[e] = silu_f(acc[ai][0][m][0][e]) * acc[ai][1][m][0][e]; v1[e] = silu_f(acc[ai][0][m][1][e]) * acc[ai][1][m][1][e]; }
                *(u32x4*)rowp = pack8(v0, v1); }
    }
};

struct EpiQKV {
    static constexpr bool PERM = true, AFTER_DRAIN = false;
    bf16_t* Q; bf16_t* Kb; bf16_t* VT; float* state_k; float* state_v; const float* rope;
    __device__ __forceinline__ void operator()(Acc& acc, const Unit& u, int wr, int wc, int fr, int fq) const {
        if (u.kind == 0) {
            const int row0 = u.pm * 256 + wr * 64 + fr;
            const int d0 = (wc >> 1) * 64 + (wc & 1) * 16 + fq * 4;
            const int i0 = (wc & 1) * 16 + fq * 4;
            const bool isq = u.pn < 4, latent = u.pm >= 32;
#pragma unroll
            for (int ai = 0; ai < 2; ++ai)
#pragma unroll
                for (int m = 0; m < 4; ++m) { const int row = row0 + ai * 128 + m * 16;
                    f32x4 cs = (f32x4){1.f, 1.f, 1.f, 1.f}, sn = (f32x4){0.f, 0.f, 0.f, 0.f};
                    if (latent) { const int t = (row - NP) & 1023; const float* rp = rope + (size_t)t * 64 + (wc >> 1) * 32 + i0; cs = *(const f32x4*)rp; sn = *(const f32x4*)(rp + 65536); }
#pragma unroll
                    for (int bj = 0; bj < 2; ++bj) { const f32x4 x0 = acc[ai][bj][m][0], x1 = acc[ai][bj][m][1]; f32x4 y0, y1;
#pragma unroll
                        for (int e = 0; e < 4; ++e) { y0[e] = x0[e] * cs[e] - x1[e] * sn[e]; y1[e] = x1[e] * cs[e] + x0[e] * sn[e]; }
                        if (isq) { bf16_t* p = Q + (size_t)row * D + (u.pn * 2 + bj) * 128 + d0;
                            u32x2 w0, w1; w0.x = cvt_pk_bf16(y0[0] * QSCALE, y0[1] * QSCALE); w0.y = cvt_pk_bf16(y0[2] * QSCALE, y0[3] * QSCALE); w1.x = cvt_pk_bf16(y1[0] * QSCALE, y1[1] * QSCALE); w1.y = cvt_pk_bf16(y1[2] * QSCALE, y1[3] * QSCALE);
                            *(u32x2*)p = w0; *(u32x2*)(p + 32) = w1; }
                        else { bf16_t* p = Kb + (size_t)row * 256 + bj * 128 + d0;
                            u32x2 w0, w1; w0.x = cvt_pk_bf16(y0[0], y0[1]); w0.y = cvt_pk_bf16(y0[2], y0[3]); w1.x = cvt_pk_bf16(y1[0], y1[1]); w1.y = cvt_pk_bf16(y1[2], y1[3]);
                            __hip_atomic_store((unsigned long long*)p, __builtin_bit_cast(unsigned long long, w0), __ATOMIC_RELAXED, __HIP_MEMORY_SCOPE_AGENT);
                            __hip_atomic_store((unsigned long long*)(p + 32), __builtin_bit_cast(unsigned long long, w1), __ATOMIC_RELAXED, __HIP_MEMORY_SCOPE_AGENT);
                            if (!latent) { float* sp = state_k + (size_t)row * 256 + bj * 128 + d0; *(f32x4*)sp = x0; *(f32x4*)(sp + 32) = x1; } } } }
        } else {
            const int ch0 = wr * 64 + fr, tok0 = u.pn * 256 + wc * 32 + 8 * fq;
#pragma unroll
            for (int ai = 0; ai < 2; ++ai)
#pragma unroll
                for (int m = 0; m < 4; ++m) { const int ch = ch0 + ai * 128 + m * 16; const __amdgpu_buffer_rsrc_t vr = __builtin_amdgcn_make_buffer_rsrc((void*)VT, (short)0, 0x7ffff000, 0x00020000); const unsigned voff = (unsigned)(ch * NTOK + tok0) * 2u;
#pragma unroll
                    for (int bj = 0; bj < 2; ++bj) { const f32x4 v0 = acc[ai][bj][m][0], v1 = acc[ai][bj][m][1];
                        __builtin_amdgcn_raw_buffer_store_b128(pack8(v0, v1), vr, voff + bj * 256u, 0, 16);
                        if (u.pn < 32) { float* sp = state_v + (size_t)(tok0 + bj * 128) * 256 + ch;
#pragma unroll
                            for (int e = 0; e < 4; ++e) { sp[(size_t)e * 256] = v0[e]; sp[(size_t)(4 + e) * 256] = v1[e]; } } } }
        }
    }
};

struct EpiFinal {
    static constexpr bool PERM = true, AFTER_DRAIN = true;
    const bf16_t* X; float* Y; const float* gate; const float* gpost; float* slots; unsigned* cnt; unsigned* bar;
    __device__ __forceinline__ void operator()(Acc&, const Unit&, int, int, int, int) const {}
    __device__ __forceinline__ void fused(Acc& acc, const Unit& u, int wr, int wc, int fr, int fq, LAS unsigned char* lds, int wid, int lane) const {
        LAS float* Pl = (LAS float*)lds;
        LAS float* Sl = (LAS float*)(lds + 4096);
#pragma unroll
        for (int ai = 0; ai < 2; ++ai)
#pragma unroll
            for (int m = 0; m < 4; ++m) { float ss = 0.f;
#pragma unroll
                for (int bj = 0; bj < 2; ++bj) { const f32x4 v0 = acc[ai][bj][m][0], v1 = acc[ai][bj][m][1];
                    ss += (v0[0] * v0[0] + v0[1] * v0[1]) + (v0[2] * v0[2] + v0[3] * v0[3]) + (v1[0] * v1[0] + v1[1] * v1[1]) + (v1[2] * v1[2] + v1[3] * v1[3]); }
                ss += __shfl_xor(ss, 16); ss += __shfl_xor(ss, 32);
                if (fq == 0) Pl[(ai * 128 + wr * 64 + m * 16 + fr) * 4 + wc] = ss; }
        __syncthreads();
        const int t = wid * 64 + lane;
        float* myslots = slots + ((size_t)u.pm * 256) * 4;
        if (t < 256) { const float sp = (Pl[t * 4 + 0] + Pl[t * 4 + 1]) + (Pl[t * 4 + 2] + Pl[t * 4 + 3]);
            __hip_atomic_store(myslots + t * 4 + u.pn, sp, __ATOMIC_RELAXED, __HIP_MEMORY_SCOPE_AGENT); }
        asm volatile("s_waitcnt vmcnt(0)" ::: "memory");
        __syncthreads();
        if (t == 0) { (void)xb_add(cnt + u.pm, 1u); XB_SPIN(xb_ld(cnt + u.pm) < 4u, bar); __builtin_amdgcn_fence(__ATOMIC_ACQUIRE, "agent"); asm volatile("s_waitcnt vmcnt(0)" ::: "memory"); }
        __syncthreads();
        if (t < 256) { float sacc = 0.f;
#pragma unroll
            for (int j = 0; j < 4; ++j) sacc += __hip_atomic_load(myslots + t * 4 + j, __ATOMIC_RELAXED, __HIP_MEMORY_SCOPE_AGENT);
            Sl[t] = rsqrtf(sacc * (1.0f / 1024.0f) + EPS); }
        __syncthreads();
        const int mrow = u.pm < 32 ? 0 : 1 + ((u.pm - 32) >> 2);
        const int col0 = u.pn * 256 + wc * 32 + 8 * fq;
#pragma unroll
        for (int bj = 0; bj < 2; ++bj) { const int c = col0 + bj * 128;
            const f32x4 g0 = *(const f32x4*)(gate + (size_t)mrow * 6144 + c) * *(const f32x4*)(gpost + c), g1 = *(const f32x4*)(gate + (size_t)mrow * 6144 + c + 4) * *(const f32x4*)(gpost + c + 4);
#pragma unroll
            for (int ai = 0; ai < 2; ++ai)
#pragma unroll
                for (int m = 0; m < 4; ++m) { const int rl = ai * 128 + wr * 64 + m * 16 + fr; const size_t row = (size_t)u.pm * 256 + rl; const float al = Sl[rl];
                    const u32x4 xw = *(const u32x4*)(X + row * D + c);
                    f32x4 y0, y1; const f32x4 a0 = acc[ai][bj][m][0], a1 = acc[ai][bj][m][1];
                    y0[0] = bf_lo(xw.x) + g0[0] * (a0[0] * al); y0[1] = bf_hi(xw.x) + g0[1] * (a0[1] * al); y0[2] = bf_lo(xw.y) + g0[2] * (a0[2] * al); y0[3] = bf_hi(xw.y) + g0[3] * (a0[3] * al);
                    y1[0] = bf_lo(xw.z) + g1[0] * (a1[0] * al); y1[1] = bf_hi(xw.z) + g1[1] * (a1[1] * al); y1[2] = bf_lo(xw.w) + g1[2] * (a1[2] * al); y1[3] = bf_hi(xw.w) + g1[3] * (a1[3] * al);
                    *(f32x4*)(Y + row * D + c) = y0; *(f32x4*)(Y + row * D + c + 4) = y1; } }
    }
};

template <bool XF32>
struct EpiResNorm {
    static constexpr bool PERM = true, AFTER_DRAIN = true;
    const float* xa; const float* xb; const bf16_t* Xin; bf16_t* Xout; bf16_t* H;
    const float* gate; const float* gpost; const float* gpre; const float* shift; const float* scale;
    float* slots1; float* slots2; unsigned* cnt1; unsigned* cnt2; unsigned* bar;
    __device__ __forceinline__ void operator()(Acc&, const Unit&, int, int, int, int) const {}
    __device__ __forceinline__ void exchange(const float (&part)[2][4], float* slots, unsigned* cntp, const Unit& u, int wr, int wc, int fr, int fq, LAS float* Pl, LAS float* Sl, int t) const {
        if (fq == 0) {
#pragma unroll
            for (int ai = 0; ai < 2; ++ai)
#pragma unroll
                for (int m = 0; m < 4; ++m) Pl[(ai * 128 + wr * 64 + m * 16 + fr) * 4 + wc] = part[ai][m]; }
        __syncthreads();
        float* myslots = slots + ((size_t)u.pm * 256) * 4;
        if (t < 256) { const float sp = (Pl[t * 4 + 0] + Pl[t * 4 + 1]) + (Pl[t * 4 + 2] + Pl[t * 4 + 3]);
            __hip_atomic_store(myslots + t * 4 + u.pn, sp, __ATOMIC_RELAXED, __HIP_MEMORY_SCOPE_AGENT); }
        asm volatile("s_waitcnt vmcnt(0)" ::: "memory");
        __syncthreads();
        if (t == 0) { (void)xb_add(cntp + u.pm, 1u); XB_SPIN(xb_ld(cntp + u.pm) < 4u, bar); __builtin_amdgcn_fence(__ATOMIC_ACQUIRE, "agent"); asm volatile("s_waitcnt vmcnt(0)" ::: "memory"); }
        __syncthreads();
        if (t < 256) { float sacc = 0.f;
#pragma unroll
            for (int j = 0; j < 4; ++j) sacc += __hip_atomic_load(myslots + t * 4 + j, __ATOMIC_RELAXED, __HIP_MEMORY_SCOPE_AGENT);
            Sl[t] = rsqrtf(sacc * (1.0f / 1024.0f) + EPS); }
        __syncthreads();
    }
    __device__ __forceinline__ void fused(Acc& acc, const Unit& u, int wr, int wc, int fr, int fq, LAS unsigned char* lds, int wid, int lane) const {
        LAS float* Pl = (LAS float*)lds; LAS float* Sl = (LAS float*)(lds + 4096);
        const int t = wid * 64 + lane;
        float part[2][4];
#pragma unroll
        for (int ai = 0; ai < 2; ++ai)
#pragma unroll
            for (int m = 0; m < 4; ++m) { float ss = 0.f;
#pragma unroll
                for (int bj = 0; bj < 2; ++bj) { const f32x4 v0 = acc[ai][bj][m][0], v1 = acc[ai][bj][m][1];
                    ss += (v0[0] * v0[0] + v0[1] * v0[1]) + (v0[2] * v0[2] + v0[3] * v0[3]) + (v1[0] * v1[0] + v1[1] * v1[1]) + (v1[2] * v1[2] + v1[3] * v1[3]); }
                ss += __shfl_xor(ss, 16); ss += __shfl_xor(ss, 32); part[ai][m] = ss; }
        exchange(part, slots1, cnt1, u, wr, wc, fr, fq, Pl, Sl, t);
        const int mrow = u.pm < 32 ? 0 : 1 + ((u.pm - 32) >> 2);
        const int col0 = u.pn * 256 + wc * 32 + 8 * fq;
#pragma unroll
        for (int ai = 0; ai < 2; ++ai)
#pragma unroll
            for (int m = 0; m < 4; ++m) part[ai][m] = 0.f;
#pragma unroll
        for (int bj = 0; bj < 2; ++bj) { const int c = col0 + bj * 128;
            const f32x4 g0 = *(const f32x4*)(gate + (size_t)mrow * 6144 + c) * *(const f32x4*)(gpost + c), g1 = *(const f32x4*)(gate + (size_t)mrow * 6144 + c + 4) * *(const f32x4*)(gpost + c + 4);
#pragma unroll
            for (int ai = 0; ai < 2; ++ai)
#pragma unroll
                for (int m = 0; m < 4; ++m) { const int rl = ai * 128 + wr * 64 + m * 16 + fr; const size_t row = (size_t)u.pm * 256 + rl; const float al = Sl[rl];
                    f32x4 x0, x1;
                    if (XF32) { const float* xr = (row < (size_t)NP ? xa + row * D : xb + (row - NP) * D) + c; x0 = *(const f32x4*)xr; x1 = *(const f32x4*)(xr + 4); }
                    else { const u32x4 xw = *(const u32x4*)(Xin + row * D + c); x0 = (f32x4){bf_lo(xw.x), bf_hi(xw.x), bf_lo(xw.y), bf_hi(xw.y)}; x1 = (f32x4){bf_lo(xw.z), bf_hi(xw.z), bf_lo(xw.w), bf_hi(xw.w)}; }
                    x0 += g0 * (acc[ai][bj][m][0] * al); x1 += g1 * (acc[ai][bj][m][1] * al);
                    const u32x4 w = pack8(x0, x1);
                    *(u32x4*)(Xout + row * D + c) = w;
                    x0 = (f32x4){bf_lo(w.x), bf_hi(w.x), bf_lo(w.y), bf_hi(w.y)}; x1 = (f32x4){bf_lo(w.z), bf_hi(w.z), bf_lo(w.w), bf_hi(w.w)};
                    acc[ai][bj][m][0] = x0; acc[ai][bj][m][1] = x1;
                    part[ai][m] += (x0[0] * x0[0] + x0[1] * x0[1]) + (x0[2] * x0[2] + x0[3] * x0[3]) + (x1[0] * x1[0] + x1[1] * x1[1]) + (x1[2] * x1[2] + x1[3] * x1[3]); } }
#pragma unroll
        for (int ai = 0; ai < 2; ++ai)
#pragma unroll
            for (int m = 0; m < 4; ++m) { float ss = part[ai][m]; ss += __shfl_xor(ss, 16); ss += __shfl_xor(ss, 32); part[ai][m] = ss; }
        exchange(part, slots2, cnt2, u, wr, wc, fr, fq, Pl, Sl, t);
#pragma unroll
        for (int bj = 0; bj < 2; ++bj) { const int c = col0 + bj * 128;
            const f32x4 gs0 = *(const f32x4*)(gpre + c) * (*(const f32x4*)(scale + (size_t)mrow * 6144 + c) + 1.0f), gs1 = *(const f32x4*)(gpre + c + 4) * (*(const f32x4*)(scale + (size_t)mrow * 6144 + c + 4) + 1.0f);
            const f32x4 sh0 = *(const f32x4*)(shift + (size_t)mrow * 6144 + c), sh1 = *(const f32x4*)(shift + (size_t)mrow * 6144 + c + 4);
#pragma unroll
            for (int ai = 0; ai < 2; ++ai)
#pragma unroll
                for (int m = 0; m < 4; ++m) { const int rl = ai * 128 + wr * 64 + m * 16 + fr; const size_t row = (size_t)u.pm * 256 + rl; const float rs = Sl[rl];
                    const f32x4 h0 = (acc[ai][bj][m][0] * rs) * gs0 + sh0, h1 = (acc[ai][bj][m][1] * rs) * gs1 + sh1;
                    *(u32x4*)(H + row * D + c) = pack8(h0, h1); } }
    }
};

typedef __amdgpu_buffer_rsrc_t rsrc_t;
struct EpiSplitK {
    static constexpr bool PERM = true, AFTER_DRAIN = true;
    bf16_t* O; int ldc, coff; float* slab; unsigned* cnt; unsigned* bar;
    __device__ __forceinline__ void operator()(Acc&, const Unit&, int, int, int, int) const {}
    __device__ __forceinline__ void fused(Acc& acc, const Unit& u, int wr, int wc, int fr, int fq, LAS unsigned char* lds, int wid, int lane) const {
        const int t = wid * 64 + lane, own = u.kind;
        const rsrc_t rs = __builtin_amdgcn_make_buffer_rsrc((void*)(slab + (size_t)blockIdx.x * 32768), (short)0, 131072, 0x00020000);
#pragma unroll
        for (int bj = 0; bj < 2; ++bj)
#pragma unroll
            for (int m = 0; m < 4; ++m)
#pragma unroll
                for (int n = 0; n < 2; ++n) { const f32x4 v = own ? acc[0][bj][m][n] : acc[1][bj][m][n];
                    __builtin_amdgcn_raw_buffer_store_b128(__builtin_bit_cast(u32x4, v), rs, (unsigned)((((bj * 4 + m) * 2 + n) * 512 + t) * 16), 0, 16); }
        asm volatile("s_waitcnt vmcnt(0)" ::: "memory");
        __syncthreads();
        if (t == 0) { unsigned* p = cnt + (blockIdx.x < (unsigned)u.pad ? blockIdx.x : (unsigned)u.pad); (void)xb_add(p, 1u); XB_SPIN(xb_ld(p) < 2u, bar);
            __builtin_amdgcn_fence(__ATOMIC_ACQUIRE, "agent"); asm volatile("s_waitcnt vmcnt(0)" ::: "memory"); }
        __syncthreads();
        const float* ps = slab + (size_t)u.pad * 32768;
        const int row0 = u.pm * 256 + own * 128 + wr * 64 + fr, col0 = coff + u.pn * 256 + wc * 32 + 8 * fq;
#pragma unroll
        for (int m = 0; m < 4; ++m)
#pragma unroll
            for (int bj = 0; bj < 2; ++bj) { f32x4 v[2];
#pragma unroll
                for (int n = 0; n < 2; ++n) { const f32x4 pv = *(const f32x4*)(ps + (size_t)(((bj * 4 + m) * 2 + n) * 512 + t) * 4); v[n] = (own ? acc[1][bj][m][n] : acc[0][bj][m][n]) + pv; }
                *(u32x4*)(O + (size_t)(row0 + m * 16) * ldc + col0 + bj * 128) = pack8(v[0], v[1]); }
    }
};

struct SchedNat {
    const char* A; const char* B; int K, nN, G, c;
    __device__ __forceinline__ bool next(int i, Unit& u) const { const int L = i * G + c; if (L >= 64 * nN) return false;
        u.kind = 0; u.pad = 0; u.pm = L & 63; u.pn = L >> 6; u.a = A + (size_t)u.pm * 256 * K * 2; u.b = B + (size_t)u.pn * 256 * K * 2; return true; }
};
struct SchedL0 {
    const char* H; const char* W; int G, c;
    __device__ __forceinline__ bool next(int i, Unit& u) const { const int L = i * G + c; if (L >= 512) return false; u.pad = 0;
        if (L < 384) { u.kind = 1; u.pm = L >> 6; u.pn = L & 63; u.a = W + (size_t)(512 + u.pm * 256) * D * 2; u.b = H + (size_t)u.pn * 256 * D * 2; }
        else { const int l = L - 384; u.kind = 0; u.pm = l & 63; u.pn = l >> 6; u.a = H + (size_t)u.pm * 256 * D * 2; u.b = W + (size_t)u.pn * 256 * D * 2; } return true; }
};
struct SchedQKV {
    const char* H; const char* W; int G, c, part;
    __device__ __forceinline__ void nat(Unit& u, int pm, int pn) const { u.kind = 0; u.pm = pm; u.pn = pn; u.a = H + (size_t)pm * 256 * D * 2; u.b = W + (size_t)pn * 256 * D * 2; }
    __device__ __forceinline__ void swp(Unit& u, int tt) const { u.kind = 1; u.pm = 0; u.pn = tt; u.a = W + (size_t)1280 * D * 2; u.b = H + (size_t)tt * 256 * D * 2; }
    __device__ __forceinline__ bool next(int i, Unit& u) const { const int L = i * G + c; u.pad = 0;
        if (part == 0) { if (L >= 256) return false;
            if (L < 128) nat(u, L & 31, L >> 5); else if (L < 160) nat(u, L - 128, 4); else if (L < 192) swp(u, L - 160); else nat(u, 32 + ((L - 192) & 31), (L - 192) >> 5); }
        else { if (L >= 128) return false;
            if (L < 64) nat(u, 32 + (L & 31), 2 + (L >> 5)); else if (L < 96) nat(u, 32 + (L - 64), 4); else swp(u, 32 + (L - 96)); }
        return true; }
};
struct SchedFH {
    const char* CS; const char* PQ; int G, c;
    __device__ __forceinline__ bool next(int i, Unit& u) const { const int L = i * G + c; if (i > 0 || L >= 128) return false;
        const int id = L & 63, kh = L >> 6, sb = id >> 3, pt = (id >> 1) & 3, pn = id & 1; u.pm = 32 + sb * 4 + pt; u.pn = pn; u.kind = kh; u.pad = L ^ 64;
        u.a = CS + ((size_t)pt * 256 * 2048 + (size_t)kh * 1024) * 2; u.b = PQ + ((size_t)8388608 + (size_t)sb * 1048576 + (size_t)pn * 256 * 2048 + (size_t)kh * 1024) * 2; return true; }
};
struct SchedFL {
    const char* CS; const char* PQ; int G, c;
    __device__ __forceinline__ bool next(int i, Unit& u) const { int kmin = c >= 128 ? 0 : (128 - c + G - 1) / G; const int L = c + (kmin + i) * G - 128; if (L >= 64) return false; u.pad = 0; u.kind = 0;
        const int b = L >> 1, pn = L & 1; u.pm = b; u.pn = pn; u.a = CS; u.b = PQ + ((size_t)b * 262144 + (size_t)pn * 256 * 512) * 2; return true; }
};

struct Params { const float* in[23]; float* out; unsigned char* ws; int ph_lo, ph_hi; };

struct TrDesc { const float* src; bf16_t* dst; int ld, col0, k0, ldd, perm, pad; };
__device__ __forceinline__ void tr_load(const TrDesc& d, f32x4 (&v)[4], int tid) {
#pragma unroll
    for (int i = 0; i < 4; ++i) { const int kk = (tid >> 5) + 16 * i, c4 = (tid & 31) * 4; v[i] = *(const f32x4*)(d.src + (size_t)(d.k0 + kk) * d.ld + d.col0 + c4); }
}
__device__ __forceinline__ void tr_put(LAS float* tile, const f32x4 (&v)[4], int tid) {
#pragma unroll
    for (int i = 0; i < 4; ++i) { const int kk = (tid >> 5) + 16 * i, c4 = (tid & 31) * 4;
        tile[kk * 129 + c4] = v[i][0]; tile[kk * 129 + c4 + 1] = v[i][1]; tile[kk * 129 + c4 + 2] = v[i][2]; tile[kk * 129 + c4 + 3] = v[i][3]; }
}
__device__ __forceinline__ void tr_store(LAS float* tile, const TrDesc& d, int tid, bool wt) {
    const int j = tid >> 2, kq = tid & 3;
    int col = j;
    if (d.perm) { const int wc = j >> 5, fq = (j >> 3) & 3, n = (j >> 2) & 1, e = j & 3, w = wc * 16 + fq * 4 + e; col = (w >> 5) * 64 + (w & 31) + 32 * n; }
    float v[16];
#pragma unroll
    for (int i = 0; i < 16; ++i) v[i] = tile[(kq * 16 + i) * 129 + col];
    u32x4 w0, w1;
    w0.x = cvt_pk_bf16(v[0], v[1]); w0.y = cvt_pk_bf16(v[2], v[3]); w0.z = cvt_pk_bf16(v[4], v[5]); w0.w = cvt_pk_bf16(v[6], v[7]);
    w1.x = cvt_pk_bf16(v[8], v[9]); w1.y = cvt_pk_bf16(v[10], v[11]); w1.z = cvt_pk_bf16(v[12], v[13]); w1.w = cvt_pk_bf16(v[14], v[15]);
    if (wt) { const __amdgpu_buffer_rsrc_t rs = __builtin_amdgcn_make_buffer_rsrc((void*)d.dst, (short)0, 0x7ffff000, 0x00020000); const unsigned off = (unsigned)(j * d.ldd + d.k0 + kq * 16) * 2u;
        __builtin_amdgcn_raw_buffer_store_b128(w0, rs, off, 0, 16); __builtin_amdgcn_raw_buffer_store_b128(w1, rs, off + 16u, 0, 16); }
    else { bf16_t* dp = d.dst + (size_t)j * d.ldd + d.k0 + kq * 16; *(u32x4*)dp = w0; *(u32x4*)(dp + 8) = w1; }
}
__device__ __forceinline__ TrDesc tr_desc(const Params& P, unsigned char* ws, int id) {
    constexpr int T_IN = 128, T_OUT = 128, T_QKV = 192, T_O = 128, T_GU = 704, T_DN = 352;
    TrDesc d; d.perm = 0; d.pad = 0;
    if (id < T_IN) { const int rt = id >> 4, kt = id & 15; d.src = P.in[12]; d.ld = 1536; d.col0 = rt * 128; d.k0 = kt * 64; d.ldd = D; d.dst = (bf16_t*)(ws + WS_WIN) + (size_t)rt * 128 * D; }
    else if ((id -= T_IN) < T_OUT) { const int rt = id >> 4, kt = id & 15; d.src = P.in[16]; d.ld = 1024; d.col0 = rt * 128; d.k0 = kt * 64; d.ldd = D; d.dst = (bf16_t*)(ws + WS_WOUT) + (size_t)rt * 128 * D; }
    else if ((id -= T_OUT) < T_QKV) { const int rt = id >> 4, kt = id & 15; d.src = P.in[17]; d.ld = 1536; d.col0 = rt * 128; d.k0 = kt * 64; d.ldd = D; d.perm = rt < 10; d.dst = (bf16_t*)(ws + WS_WQKV) + (size_t)rt * 128 * D; }
    else if ((id -= T_QKV) < T_O) { const int rt = id >> 4, kt = id & 15; d.src = P.in[19]; d.ld = 1024; d.col0 = rt * 128; d.k0 = kt * 64; d.ldd = D; d.dst = (bf16_t*)(ws + WS_WO) + (size_t)rt * 128 * D; }
    else if ((id -= T_O) < 2 * T_GU) { const int l = id / T_GU, r = id % T_GU, rt = r >> 4, kt = r & 15, pn = rt >> 1, bj = rt & 1;
        d.src = (bj ? P.in[21] : P.in[20]) + (size_t)l * D * DFF; d.ld = DFF; d.col0 = pn * 128; d.k0 = kt * 64; d.ldd = D; d.dst = (bf16_t*)(ws + WS_WGU) + ((size_t)l * 5632 + (size_t)rt * 128) * D; }
    else { id -= 2 * T_GU; const int l = id / T_DN, r = id % T_DN, rt = r / 44, kt = r % 44;
        d.src = P.in[22] + (size_t)l * DFF * D; d.ld = D; d.col0 = rt * 128; d.k0 = kt * 64; d.ldd = DFF; d.dst = (bf16_t*)(ws + WS_WDN) + ((size_t)l * 1024 + (size_t)rt * 128) * DFF; }
    return d;
}

constexpr int TR_N0 = 128 + 128 + 704 + 352, TR_N1 = 0, TR_N2 = 192 + 128 + 704 + 352;
__device__ __forceinline__ int tr_map(int list, int j) {
    if (list == 0) return j < 256 ? j : (j < 256 + 704 ? 576 + (j - 256) : 1984 + (j - 960));
    if (list == 1) return 256 + j;
    return j < 320 ? 256 + j : (j < 320 + 704 ? 1280 + (j - 320) : 2336 + (j - 1024));
}
__device__ __forceinline__ int start_after(int c, int n_before, int G) { int it = c; while (it < n_before) it += G; return it - n_before; }
__device__ __forceinline__ void tr_run(const Params& P, unsigned char* ws, LAS float* tile, int list, int j0, int step, int tid) {
    const int n = list == 0 ? TR_N0 : (list == 1 ? TR_N1 : TR_N2);
    int j = j0; bool valid = j < n;
    TrDesc d; f32x4 v[4];
    if (valid) { d = tr_desc(P, ws, tr_map(list, j)); tr_load(d, v, tid); }
    while (valid) {
        tr_put(tile, v, tid);
        __syncthreads();
        const int nj = j + step; const bool nvalid = nj < n; TrDesc nd = d;
        if (nvalid) { nd = tr_desc(P, ws, tr_map(list, nj)); tr_load(nd, v, tid); }
        tr_store(tile, d, tid, list == 2);
        __syncthreads();
        j = nj; valid = nvalid; d = nd;
    }
}

__device__ __forceinline__ void p0_prologue(const Params& P, LAS unsigned char* lds, int tid) {
    unsigned char* ws = P.ws;
    LAS float* tile = (LAS float*)lds;
    const int G = gridDim.x;
    constexpr int N_FOLD = 64, N_MOD = 96, N_CS = 68, N_CACHE = 16, N_ZERO = 9;
    constexpr int I_MOD = N_FOLD, I_CS = I_MOD + N_MOD, I_CACHE = I_CS + N_CS, I_ZERO = I_CACHE + N_CACHE, I_TR = I_ZERO + N_ZERO;
    constexpr int T_IN = 128, T_OUT = 128, T_QKV = 192, T_O = 128, T_GU = 704, T_DN = 352;
    constexpr int N_TR = T_IN + T_OUT + T_QKV + T_O + 2 * T_GU + 2 * T_DN;
    for (int it = blockIdx.x; it < I_TR; it += G) {
        if (it < I_MOD) {
            const int g = it >> 4, kt = it & 15;
            LAS float* tab = tile + 64 * 129;
            const float* src = P.in[12];
#pragma unroll
            for (int i = 0; i < 4; ++i) { const int kk = (tid >> 5) + 16 * i, c4 = (tid & 31) * 4;
                const f32x4 v = *(const f32x4*)(src + (size_t)(kt * 64 + kk) * 1536 + 1024 + g * 128 + c4);
                tile[kk * 129 + c4] = v[0]; tile[kk * 129 + c4 + 1] = v[1]; tile[kk * 129 + c4 + 2] = v[2]; tile[kk * 129 + c4 + 3] = v[3]; }
            if (tid < 128) tab[tid] = cosf((float)tid * (6.283185307179586f / 128.0f)) * 0.08838834764831845f;
            __syncthreads();
            const int c = tid & 127, kg = tid >> 7;
            float aP[16], aQ[16];
#pragma unroll
            for (int i = 0; i < 16; ++i) { aP[i] = 0.f; aQ[i] = 0.f; }
            for (int cp = 0; cp < 128; ++cp) { const int mi = (c * cp) & 127; const float tc = tab[mi], ts = tab[(mi + 96) & 127];
#pragma unroll
                for (int i = 0; i < 16; ++i) { const float x = tile[(kg * 16 + i) * 129 + cp]; aP[i] += x * tc; aQ[i] += x * ts; } }
            bf16_t* W = (bf16_t*)(ws + WS_WIN);
            u32x4 w0, w1;
            w0.x = cvt_pk_bf16(aP[0], aP[1]); w0.y = cvt_pk_bf16(aP[2], aP[3]); w0.z = cvt_pk_bf16(aP[4], aP[5]); w0.w = cvt_pk_bf16(aP[6], aP[7]);
            w1.x = cvt_pk_bf16(aP[8], aP[9]); w1.y = cvt_pk_bf16(aP[10], aP[11]); w1.z = cvt_pk_bf16(aP[12], aP[13]); w1.w = cvt_pk_bf16(aP[14], aP[15]);
            bf16_t* dp = W + (size_t)(1024 + g * 128 + c) * D + kt * 64 + kg * 16; *(u32x4*)dp = w0; *(u32x4*)(dp + 8) = w1;
            w0.x = cvt_pk_bf16(aQ[0], aQ[1]); w0.y = cvt_pk_bf16(aQ[2], aQ[3]); w0.z = cvt_pk_bf16(aQ[4], aQ[5]); w0.w = cvt_pk_bf16(aQ[6], aQ[7]);
            w1.x = cvt_pk_bf16(aQ[8], aQ[9]); w1.y = cvt_pk_bf16(aQ[10], aQ[11]); w1.z = cvt_pk_bf16(aQ[12], aQ[13]); w1.w = cvt_pk_bf16(aQ[14], aQ[15]);
            dp = W + (size_t)(1536 + g * 128 + c) * D + kt * 64 + kg * 16; *(u32x4*)dp = w0; *(u32x4*)(dp + 8) = w1;
            __syncthreads();
        } else if (it < I_CS) {
            const int id = it - I_MOD, l = id / 48, cgp = id % 48;
            LAS float* sc = tile;
            LAS float* red = tile + 9 * 1024;
            for (int idx = tid; idx < 9 * 1024; idx += 512) { const int r = idx >> 10, k = idx & 1023; const float v = r == 0 ? P.in[5][k] : P.in[4][(r - 1) * 1024 + k]; sc[idx] = v / (1.0f + expf(-v)); }
            __syncthreads();
            const int c4 = (tid & 31) * 4, kg = tid >> 5;
            const float* wp = P.in[6] + (size_t)l * 1024 * 6144 + (size_t)(kg * 64) * 6144 + cgp * 128 + c4;
            f32x4 a[9];
#pragma unroll
            for (int r = 0; r < 9; ++r) a[r] = (f32x4){0.f, 0.f, 0.f, 0.f};
            for (int k = 0; k < 64; k += 16) { f32x4 w[16];
#pragma unroll
                for (int j = 0; j < 16; ++j) w[j] = *(const f32x4*)(wp + (size_t)(k + j) * 6144);
#pragma unroll
                for (int j = 0; j < 16; ++j)
#pragma unroll
                    for (int r = 0; r < 9; ++r) { const float sv = sc[r * 1024 + kg * 64 + k + j]; a[r] += w[j] * sv; } }
#pragma unroll
            for (int r = 0; r < 9; ++r) *(LAS f32x4*)(red + (kg * 9 + r) * 128 + c4) = a[r];
            __syncthreads();
            float* MOD = (float*)(ws + WS_MOD);
            for (int idx = tid; idx < 9 * 128; idx += 512) { const int r = idx >> 7, cc = idx & 127; float sacc = 0.f;
#pragma unroll
                for (int g2 = 0; g2 < 16; ++g2) sacc += red[(g2 * 9 + r) * 128 + cc];
                MOD[((size_t)l * 9 + r) * 6144 + cgp * 128 + cc] = sacc + P.in[7][l * 6144 + cgp * 128 + cc]; }
            __syncthreads();
        } else if (it < I_CACHE) {
            const int id = it - I_CS;
            const bool big = id < 64; const int T = big ? 1024 : 256; const float sc = big ? (1.0f / 32.0f) : (1.0f / 16.0f);
            bf16_t* tabp = (bf16_t*)(ws + (big ? WS_CS1024 : WS_CS256));
            const int e0 = (big ? id : id - 64) * 32768;
            for (int ch = tid; ch < 4096; ch += 512) { const int e = e0 + ch * 8; const int t = e / (2 * T), kk0 = e % (2 * T);
                float v[8];
#pragma unroll
                for (int j = 0; j < 8; ++j) { const int kk = kk0 + j, jj = kk & (T - 1), mi = (t * jj) & (T - 1); const float rev = (float)mi / (float)T;
                    const float s = __builtin_amdgcn_sinf(rev), c = __builtin_amdgcn_cosf(rev); v[j] = (kk < T ? c : -s) * sc; }
                u32x4 w; w.x = cvt_pk_bf16(v[0], v[1]); w.y = cvt_pk_bf16(v[2], v[3]); w.z = cvt_pk_bf16(v[4], v[5]); w.w = cvt_pk_bf16(v[6], v[7]);
                *(u32x4*)(tabp + e) = w; }
        } else if (it < I_ZERO) {
            const int id = it - I_CACHE;
            if (id < 8) { bf16_t* CK = (bf16_t*)(ws + WS_CK);
                for (int ch = tid; ch < 8192; ch += 512) { const int e = id * 65536 + ch * 8; const int d0 = e & 127, pos = (e >> 7) & 255, kv = (e >> 15) & 1, b = e >> 16;
                    const float* sp = P.in[2] + ((size_t)(b * 256 + pos) * 2 + kv) * 128 + d0; const f32x4 a = *(const f32x4*)sp, c = *(const f32x4*)(sp + 4);
                    *(u32x4*)(CK + e) = pack8(a, c); } }
            else { bf16_t* CVT = (bf16_t*)(ws + WS_CVT);
                for (int ch = tid; ch < 8192; ch += 512) { const int e = (id - 8) * 65536 + ch * 8; const int pos0 = e & 255, d = (e >> 8) & 127, kv = (e >> 15) & 1, b = e >> 16;
                    float v[8];
#pragma unroll
                    for (int j = 0; j < 8; ++j) v[j] = P.in[3][((size_t)(b * 256 + pos0 + j) * 2 + kv) * 128 + d];
                    u32x4 w; w.x = cvt_pk_bf16(v[0], v[1]); w.y = cvt_pk_bf16(v[2], v[3]); w.z = cvt_pk_bf16(v[4], v[5]); w.w = cvt_pk_bf16(v[6], v[7]);
                    *(u32x4*)(CVT + e) = w; } }
        } else if (it < I_TR) {
            const int id = it - I_ZERO;
            if (id == 0) { f32x4* z = (f32x4*)(ws + WS_STATS);
                for (int i = tid; i < (6 * 16384) / 4; i += 512) z[i] = (f32x4){0.f, 0.f, 0.f, 0.f}; }
            else { float* rope = (float*)(ws + WS_ROPE);
                for (int e = (id - 1) * 8192 + tid; e < id * 8192; e += 512) { const int t = e >> 6, jx = e & 63, ax = jx >> 5, i = jx & 31;
                    const float inv = powf(10000.0f, -(float)(2 * i) / 64.0f), pos = (float)(ax ? (t & 63) : (t >> 6)), ang = pos * inv;
                    float sv, cv; sincosf(ang, &sv, &cv); rope[e] = cv; rope[65536 + e] = sv; } }
        }
    }
    tr_run(P, ws, tile, 0, start_after(blockIdx.x, I_TR, G), G, tid);
}

template <int MODE>
__device__ __forceinline__ void ew_phase(const float* xa, const float* xb, const bf16_t* Xin, const bf16_t* Gm, const float* rowss, const float* gate, const float* gpost,
                                         bf16_t* Xout, float* Y, bf16_t* H, const float* gpre, const float* shift, const float* scale, int tid) {
    constexpr int R = 4;
    const int lane = tid & 63;
    const int first = (int)(blockIdx.x & 63) * 256 + (int)(blockIdx.x >> 6) * 64 + (tid >> 6) * 8;
    for (int r0 = first; r0 < first + 8; r0 += R) {
        const int mrow = r0 < NP ? 0 : 1 + ((r0 - NP) >> 10);
        f32x4 x[R][4]; u32x2 gq[R][4]; float alpha[R];
#pragma unroll
        for (int i = 0; i < R; ++i) { const int r = r0 + i;
            if (MODE <= 1) { const float* xr = r < NP ? xa + (size_t)r * D : xb + (size_t)(r - NP) * D;
#pragma unroll
                for (int j = 0; j < 4; ++j) x[i][j] = *(const f32x4*)(xr + j * 256 + lane * 4); }
            else {
#pragma unroll
                for (int j = 0; j < 4; ++j) { const u32x2 w = *(const u32x2*)(Xin + (size_t)r * D + j * 256 + lane * 4); x[i][j] = (f32x4){bf_lo(w.x), bf_hi(w.x), bf_lo(w.y), bf_hi(w.y)}; } }
            if (MODE != 0) { alpha[i] = rowss[r];
#pragma unroll
                for (int j = 0; j < 4; ++j) gq[i][j] = *(const u32x2*)(Gm + (size_t)r * D + j * 256 + lane * 4); } }
        if (MODE != 0) {
#pragma unroll
            for (int j = 0; j < 4; ++j) { const int c = j * 256 + lane * 4;
                const f32x4 gt = *(const f32x4*)(gate + (size_t)mrow * 6144 + c), gp = *(const f32x4*)(gpost + c);
                const f32x4 gg = gt * gp;
#pragma unroll
                for (int i = 0; i < R; ++i) { const int r = r0 + i; const float al = rsqrtf(alpha[i] * (1.0f / 1024.0f) + EPS);
                    x[i][j][0] += gg[0] * (bf_lo(gq[i][j].x) * al); x[i][j][1] += gg[1] * (bf_hi(gq[i][j].x) * al);
                    x[i][j][2] += gg[2] * (bf_lo(gq[i][j].y) * al); x[i][j][3] += gg[3] * (bf_hi(gq[i][j].y) * al);
                    if (MODE == 3) *(f32x4*)(Y + (size_t)r * D + c) = x[i][j];
                    else { u32x2 w; w.x = cvt_pk_bf16(x[i][j][0], x[i][j][1]); w.y = cvt_pk_bf16(x[i][j][2], x[i][j][3]); *(u32x2*)(Xout + (size_t)r * D + c) = w;
                           x[i][j] = (f32x4){bf_lo(w.x), bf_hi(w.x), bf_lo(w.y), bf_hi(w.y)}; } } }
        }
        if (MODE != 3) {
            float rs[R];
#pragma unroll
            for (int i = 0; i < R; ++i) { float ss = 0.f;
#pragma unroll
                for (int j = 0; j < 4; ++j) ss += (x[i][j][0] * x[i][j][0] + x[i][j][1] * x[i][j][1]) + (x[i][j][2] * x[i][j][2] + x[i][j][3] * x[i][j][3]);
                rs[i] = ss; }
#pragma unroll
            for (int sft = 1; sft < 64; sft <<= 1)
#pragma unroll
                for (int i = 0; i < R; ++i) rs[i] += __shfl_xor(rs[i], sft);
#pragma unroll
            for (int i = 0; i < R; ++i) rs[i] = rsqrtf(rs[i] * (1.0f / 1024.0f) + EPS);
#pragma unroll
            for (int j = 0; j < 4; ++j) { const int c = j * 256 + lane * 4;
                const f32x4 g = *(const f32x4*)(gpre + c), sh = *(const f32x4*)(shift + (size_t)mrow * 6144 + c), sl = *(const f32x4*)(scale + (size_t)mrow * 6144 + c);
                const f32x4 gs = g * (sl + 1.0f);
#pragma unroll
                for (int i = 0; i < R; ++i) { f32x4 h;
#pragma unroll
                    for (int e = 0; e < 4; ++e) h[e] = (x[i][j][e] * rs[i]) * gs[e] + sh[e];
                    u32x2 w; w.x = cvt_pk_bf16(h[0], h[1]); w.y = cvt_pk_bf16(h[2], h[3]);
                    *(u32x2*)(H + (size_t)(r0 + i) * D + c) = w; } }
        }
    }
}

__device__ __forceinline__ void gmlp_item(LAS unsigned char* lds, int id, const float* sgu_w, const float* sgu_b, const float* sgu_g,
                                          const bf16_t* U, const bf16_t* VT, bf16_t* AB, int tid, bool need_stats) {
    const int chunk = id >> 2, h = id & 3, tok0 = chunk * 128;
    LAS bf16_t* Wl = (LAS bf16_t*)lds;
    LAS bf16_t* Vl = (LAS bf16_t*)(lds + 128 * 136 * 2);
    LAS float* rl = (LAS float*)(lds + 2 * 128 * 136 * 2);
    LAS float* rmu = rl + 128; LAS float* betal = rmu + 128;
    if (need_stats) {
        LAS float* red = betal + 128;
        const int tc = tid & 15, cg = tid >> 4; float sm[8], sq[8];
#pragma unroll
        for (int e = 0; e < 8; ++e) { sm[e] = 0.f; sq[e] = 0.f; }
#pragma unroll 4
        for (int j = 0; j < 16; ++j) { const u32x4 v = *(const u32x4*)(VT + (size_t)(cg * 16 + j) * NTOK + tok0 + tc * 8);
            const unsigned wv[4] = {v.x, v.y, v.z, v.w};
#pragma unroll
            for (int e = 0; e < 4; ++e) { const float lo = bf_lo(wv[e]), hi = bf_hi(wv[e]); sm[2 * e] += lo; sq[2 * e] += lo * lo; sm[2 * e + 1] += hi; sq[2 * e + 1] += hi * hi; } }
#pragma unroll
        for (int e = 0; e < 8; ++e) { sm[e] += __shfl_xor(sm[e], 16); sm[e] += __shfl_xor(sm[e], 32); sq[e] += __shfl_xor(sq[e], 16); sq[e] += __shfl_xor(sq[e], 32); }
        if ((tid & 63) < 16) {
#pragma unroll
            for (int e = 0; e < 8; ++e) { red[((tid >> 6) * 2 + 0) * 128 + tc * 8 + e] = sm[e]; red[((tid >> 6) * 2 + 1) * 128 + tc * 8 + e] = sq[e]; } }
        __syncthreads();
        if (tid < 128) { float s = 0.f, q = 0.f;
#pragma unroll
            for (int w8 = 0; w8 < 8; ++w8) { s += red[(w8 * 2 + 0) * 128 + tid]; q += red[(w8 * 2 + 1) * 128 + tid]; }
            const float mu = s * (1.0f / 512.0f), var = q * (1.0f / 512.0f) - mu * mu, r = rsqrtf(var + EPS); rl[tid] = r; rmu[tid] = r * mu; }
    }
#pragma unroll
    for (int i = 0; i < 4; ++i) { const int cidx = tid + 512 * i, row = cidx >> 4, cc = cidx & 15;
        const u32x4 v = *(const u32x4*)(VT + (size_t)(h * 128 + row) * NTOK + tok0 + cc * 8);
        *(LAS u32x4*)(Vl + row * 136 + cc * 8) = v; }
    __syncthreads();
    { const int p = tid >> 2, q0 = (tid & 3) * 32; const float* wp = sgu_w + ((size_t)h * 128 + p) * 128 + q0; float beta = 0.f;
#pragma unroll
        for (int j = 0; j < 32; j += 4) { const f32x4 w = *(const f32x4*)(wp + j); float ws4[4];
#pragma unroll
            for (int e = 0; e < 4; ++e) { ws4[e] = w[e] * rl[q0 + j + e]; beta += w[e] * rmu[q0 + j + e]; }
            u32x2 pk; pk.x = cvt_pk_bf16(ws4[0], ws4[1]); pk.y = cvt_pk_bf16(ws4[2], ws4[3]);
            *(LAS u32x2*)(Wl + p * 136 + q0 + j) = pk; }
        beta += __shfl_xor(beta, 1); beta += __shfl_xor(beta, 2);
        if ((tid & 3) == 0) betal[p] = beta; }
    __syncthreads();
    const int w = tid >> 6, lane = tid & 63, l15 = lane & 15, s = lane >> 4;
    f32x4 acc[8];
#pragma unroll
    for (int cb = 0; cb < 8; ++cb) acc[cb] = (f32x4){0.f, 0.f, 0.f, 0.f};
#pragma unroll
    for (int ks = 0; ks < 4; ++ks) { const bf16x8 bw = *(const LAS bf16x8*)(Wl + (16 * w + l15) * 136 + ks * 32 + s * 8);
#pragma unroll
        for (int cb = 0; cb < 8; ++cb) { const bf16x8 av = *(const LAS bf16x8*)(Vl + (cb * 16 + l15) * 136 + ks * 32 + s * 8);
            acc[cb] = __builtin_amdgcn_mfma_f32_16x16x32_bf16(av, bw, acc[cb], 0, 0, 0); } }
    const int p = 16 * w + l15; const float beta = betal[p], bp = sgu_b[h * 128 + p];
    const size_t trow = (size_t)(tok0 + p);
#pragma unroll
    for (int cb = 0; cb < 8; ++cb) { const int c = h * 128 + cb * 16 + 4 * s;
        const f32x4 g = *(const f32x4*)(sgu_g + c); const u32x2 uu = *(const u32x2*)(U + trow * 512 + c);
        const float a0 = bf_lo(uu.x) * (g[0] * (acc[cb][0] - beta) + bp), a1 = bf_hi(uu.x) * (g[1] * (acc[cb][1] - beta) + bp);
        const float a2 = bf_lo(uu.y) * (g[2] * (acc[cb][2] - beta) + bp), a3 = bf_hi(uu.y) * (g[3] * (acc[cb][3] - beta) + bp);
        u32x2 o; o.x = cvt_pk_bf16(a0, a1); o.y = cvt_pk_bf16(a2, a3);
        *(u32x2*)(AB + trow * D + c) = o; }
    __syncthreads();
}

__device__ __forceinline__ void attn_item(LAS unsigned char* lds, int it, const bf16_t* Q, const bf16_t* Kb, const bf16_t* VT, const bf16_t* CK, const bf16_t* CVT,
                                          const float* sink, bf16_t* AO, int tid) {
    LAS bf16_t* Kl = (LAS bf16_t*)lds;
    LAS bf16_t* Vl = (LAS bf16_t*)(lds + 64 * 136 * 2);
    const bool latent = it < 256;
    int b, head, row0, nband = 0, kb0 = 0, ntiles, start = 0;
    if (latent) { const int qb = it & 3; head = (it >> 2) & 7; b = it >> 5; start = qb * 256; row0 = NP + b * 1024 + start;
        kb0 = start - 128 < 0 ? 0 : start - 128; const int kb1 = start + 384 > 1024 ? 1024 : start + 384; nband = (kb1 - kb0) >> 6; ntiles = nband + 4; }
    else { const int id = it - 256; b = id & 31; head = 2 * ((id >> 5) & 3) + (id >> 7); row0 = b * 256; ntiles = 4; }
    const int kv = head >> 2;
    const int w = tid >> 6, lane = tid & 63, l15 = lane & 15, s = lane >> 4;
    const int qmin = start + 32 * w, qmax = qmin + 31;
    bf16x8 qf[2][4];
#pragma unroll
    for (int qi = 0; qi < 2; ++qi)
#pragma unroll
        for (int ks = 0; ks < 4; ++ks) qf[qi][ks] = *(const bf16x8*)(Q + (size_t)(row0 + 32 * w + 16 * qi + l15) * D + head * 128 + ks * 32 + s * 8);
    const float sk2 = sink[head] * LOG2E;
    float mrun[2] = {sk2, sk2}, lrun[2]; lrun[0] = lrun[1] = (s == 0) ? 1.0f : 0.0f;
    f32x4 o[2][8];
#pragma unroll
    for (int qi = 0; qi < 2; ++qi)
#pragma unroll
        for (int db = 0; db < 8; ++db) o[qi][db] = (f32x4){0.f, 0.f, 0.f, 0.f};
    u32x4 kregA[2], vregA[2], kregB[2], vregB[2];
    auto gload = [&](int t, u32x4 (&kreg)[2], u32x4 (&vreg)[2]) {
        const bf16_t* ks_; int kstr; const bf16_t* vs_; int vstr;
        if (latent && t >= nband) { const int c0 = (t - nband) * 64; ks_ = CK + ((size_t)(b * 2 + kv) * 256 + c0) * 128; kstr = 128; vs_ = CVT + (size_t)(b * 2 + kv) * 128 * 256 + c0; vstr = 256; }
        else { const int tokb = latent ? NP + b * 1024 + kb0 + t * 64 : b * 256 + t * 64; ks_ = Kb + (size_t)tokb * 256 + kv * 128; kstr = 256; vs_ = VT + (size_t)(kv * 128) * NTOK + tokb; vstr = NTOK; }
#pragma unroll
        for (int i = 0; i < 2; ++i) { const int cidx = tid + 512 * i;
            kreg[i] = *(const u32x4*)(ks_ + (size_t)(cidx >> 4) * kstr + (cidx & 15) * 8);
            vreg[i] = *(const u32x4*)(vs_ + (size_t)(cidx >> 3) * vstr + (cidx & 7) * 8); }
    };
    auto stage = [&](const u32x4 (&kreg)[2], const u32x4 (&vreg)[2]) {
        __syncthreads();
#pragma unroll
        for (int i = 0; i < 2; ++i) { const int cidx = tid + 512 * i;
            *(LAS u32x4*)(Kl + (cidx >> 4) * 136 + (cidx & 15) * 8) = kreg[i];
            *(LAS u32x4*)(Vl + (cidx >> 3) * 72 + (cidx & 7) * 8) = vreg[i]; }
        __syncthreads();
    };
    auto compute = [&](int t) {
        const bool band = latent && t < nband;
        const int kp0 = kb0 + t * 64;
        if (band && (kp0 > qmax + 128 || kp0 + 63 < qmin - 128)) return;
        f32x4 sc[2][4];
        {
            bf16x8 kf[2][4];
#pragma unroll
            for (int ks = 0; ks < 4; ++ks) kf[0][ks] = *(const LAS bf16x8*)(Kl + l15 * 136 + ks * 32 + s * 8);
#pragma unroll
            for (int nb = 0; nb < 4; ++nb) {
                if (nb < 3) {
#pragma unroll
                    for (int ks = 0; ks < 4; ++ks) kf[(nb + 1) & 1][ks] = *(const LAS bf16x8*)(Kl + ((nb + 1) * 16 + l15) * 136 + ks * 32 + s * 8); }
                __builtin_amdgcn_sched_barrier(0);
                sc[0][nb] = (f32x4){0.f, 0.f, 0.f, 0.f}; sc[1][nb] = (f32x4){0.f, 0.f, 0.f, 0.f};
#pragma unroll
                for (int ks = 0; ks < 4; ++ks) {
                    sc[0][nb] = __builtin_amdgcn_mfma_f32_16x16x32_bf16(kf[nb & 1][ks], qf[0][ks], sc[0][nb], 0, 0, 0);
                    sc[1][nb] = __builtin_amdgcn_mfma_f32_16x16x32_bf16(kf[nb & 1][ks], qf[1][ks], sc[1][nb], 0, 0, 0); }
                __builtin_amdgcn_sched_barrier(0);
            }
        }
        bf16x8 pf[2][2];
#pragma unroll
        for (int qi = 0; qi < 2; ++qi) {
            if (band) { const int qpos = qmin + 16 * qi + l15, kpb = kp0 + 4 * s;
#pragma unroll
                for (int nb = 0; nb < 4; ++nb)
#pragma unroll
                    for (int i = 0; i < 4; ++i) { const int dlt = qpos - (kpb + nb * 16 + i); if (dlt > 128 || dlt < -128) sc[qi][nb][i] = -1e30f; } }
            float tmax = -1e30f;
#pragma unroll
            for (int nb = 0; nb < 4; ++nb) tmax = fmaxf(tmax, fmaxf(fmaxf(sc[qi][nb][0], sc[qi][nb][1]), fmaxf(sc[qi][nb][2], sc[qi][nb][3])));
            tmax = fmaxf(tmax, __shfl_xor(tmax, 16)); tmax = fmaxf(tmax, __shfl_xor(tmax, 32));
            const float mnew = fmaxf(mrun[qi], tmax), corr = fast_exp2(mrun[qi] - mnew); mrun[qi] = mnew;
            float psum = 0.f;
#pragma unroll
            for (int nb = 0; nb < 4; ++nb)
#pragma unroll
                for (int i = 0; i < 4; ++i) { sc[qi][nb][i] = fast_exp2(sc[qi][nb][i] - mnew); psum += sc[qi][nb][i]; }
            lrun[qi] = lrun[qi] * corr + psum;
#pragma unroll
            for (int db = 0; db < 8; ++db) o[qi][db] *= corr;
#pragma unroll
            for (int kk = 0; kk < 2; ++kk) { u32x4 pw; pw.x = cvt_pk_bf16(sc[qi][2 * kk][0], sc[qi][2 * kk][1]); pw.y = cvt_pk_bf16(sc[qi][2 * kk][2], sc[qi][2 * kk][3]);
                pw.z = cvt_pk_bf16(sc[qi][2 * kk + 1][0], sc[qi][2 * kk + 1][1]); pw.w = cvt_pk_bf16(sc[qi][2 * kk + 1][2], sc[qi][2 * kk + 1][3]); pf[qi][kk] = __builtin_bit_cast(bf16x8, pw); }
        }
        {
            u32x2 vq[2][2][2][2];
            auto vload = [&](int g, int buf) {
#pragma unroll
                for (int dd = 0; dd < 2; ++dd)
#pragma unroll
                    for (int kk = 0; kk < 2; ++kk) { const LAS bf16_t* vp = Vl + ((2 * g + dd) * 16 + l15) * 72 + kk * 32 + 4 * s;
                        vq[buf][dd][kk][0] = *(const LAS u32x2*)vp; vq[buf][dd][kk][1] = *(const LAS u32x2*)(vp + 16); } };
            vload(0, 0);
#pragma unroll
            for (int g = 0; g < 4; ++g) {
                if (g < 3) vload(g + 1, (g + 1) & 1);
                __builtin_amdgcn_sched_barrier(0);
#pragma unroll
                for (int dd = 0; dd < 2; ++dd)
#pragma unroll
                    for (int kk = 0; kk < 2; ++kk) { u32x4 vw; vw.x = vq[g & 1][dd][kk][0].x; vw.y = vq[g & 1][dd][kk][0].y; vw.z = vq[g & 1][dd][kk][1].x; vw.w = vq[g & 1][dd][kk][1].y;
                        const bf16x8 vf = __builtin_bit_cast(bf16x8, vw);
                        o[0][2 * g + dd] = __builtin_amdgcn_mfma_f32_16x16x32_bf16(vf, pf[0][kk], o[0][2 * g + dd], 0, 0, 0);
                        o[1][2 * g + dd] = __builtin_amdgcn_mfma_f32_16x16x32_bf16(vf, pf[1][kk], o[1][2 * g + dd], 0, 0, 0); }
                __builtin_amdgcn_sched_barrier(0);
            }
        }
    };
    gload(0, kregA, vregA); gload(1, kregB, vregB);
    for (int t = 0; t < ntiles; t += 2) {
        stage(kregA, vregA); if (t + 2 < ntiles) gload(t + 2, kregA, vregA); compute(t);
        stage(kregB, vregB); if (t + 3 < ntiles) gload(t + 3, kregB, vregB); compute(t + 1);
    }
#pragma unroll
    for (int qi = 0; qi < 2; ++qi) {
        float l = lrun[qi]; l += __shfl_xor(l, 16); l += __shfl_xor(l, 32);
        const float inv = 1.0f / l;
        bf16_t* op = AO + (size_t)(row0 + 32 * w + 16 * qi + l15) * D + head * 128 + 4 * s;
#pragma unroll
        for (int db = 0; db < 8; ++db) { u32x2 ow; ow.x = cvt_pk_bf16(o[qi][db][0] * inv, o[qi][db][1] * inv); ow.y = cvt_pk_bf16(o[qi][db][2] * inv, o[qi][db][3] * inv); *(u32x2*)(op + db * 16) = ow; }
    }
    __syncthreads();
}

__global__ void __launch_bounds__(512, 2) fwd_kernel(Params P) {
    extern __shared__ __attribute__((aligned(16))) unsigned char lds_raw[];
    LAS unsigned char* lds = (LAS unsigned char*)lds_raw;
    const int tid = threadIdx.x;
    const int G = gridDim.x, c = blockIdx.x;
    unsigned char* ws = P.ws;
    const int lo = P.ph_lo, hi = P.ph_hi;
    float* MOD = (float*)(ws + WS_MOD);
    float* rowss = (float*)(ws + WS_STATS);
    float* vstat = rowss + 4 * 16384;
    bf16_t* H = (bf16_t*)(ws + WS_H);
    bf16_t* R2 = (bf16_t*)(ws + WS_R2);
    bf16_t* R3 = (bf16_t*)(ws + WS_R3);
    bf16_t* HF = (bf16_t*)(ws + WS_R1);
    bf16_t* X = (bf16_t*)(ws + WS_X);
#ifndef PHASE_MASK
#define PHASE_MASK 0xffff
#endif
    volatile LAS unsigned* xst = (volatile LAS unsigned*)(lds + LDS_BYTES - 64);
    if (tid < 2) xst[tid] = 0u;
    __syncthreads();
#if !MK_PER_PHASE
    XcdBarrier xbar = xcd_barrier_post((unsigned*)(ws + WS_BAR), xst);
#else
    XcdBarrier xbar; xbar.bar = nullptr; xbar.x = 0; xbar.st = xst;
#endif
#ifndef REPEAT_MASK
#define REPEAT_MASK 0
#endif
#define REP(k) (((REPEAT_MASK) >> (k)) & 1)
#define IN(k) ((((PHASE_MASK) >> (k)) & 1) && lo <= (k) && (k) < hi)
#if MK_PER_PHASE
#define SEAM(k) do {} while (0)
#define GSEAM(k, kn, idx) do {} while (0)
#else
#define SEAM(k) do { if (IN(k) && IN((k) + 1)) xcd_barrier(xbar); } while (0)
#define GSEAM(k, kn, idx) do { if (IN(k) && IN(kn)) grp_sync((unsigned*)(ws + WS_BAR) + XCD_BAR_WORDS + 1024 + ((idx) * 64 + (c & 63)) * 4, (unsigned*)(ws + WS_BAR)); } while (0)
#endif
    if (hi > 1000) cg::this_grid().sync();
    if (IN(0)) for (int rep = 0; rep <= REP(0); ++rep) { if (rep) xcd_barrier(xbar); p0_prologue(P, lds, tid); } SEAM(0);
    if (IN(1)) { ew_phase<0>(P.in[0], P.in[1], nullptr, nullptr, nullptr, nullptr, nullptr, nullptr, nullptr, H, P.in[8], MOD + 0 * 1024, MOD + 1 * 1024, tid); } GSEAM(1, 2, 4);
    if (IN(2)) for (int rep = 0; rep <= REP(2); ++rep) { if (rep) xcd_barrier(xbar); SchedL0 S{(const char*)H, (const char*)(ws + WS_WIN), G, c};
        EpiL0 E{(bf16_t*)(ws + WS_R1 + R1_U), (bf16_t*)(ws + WS_R1 + R1_VT0), (bf16_t*)(ws + WS_R1 + R1_PQT)};
        pg8::gemm_phase(lds, D, S, E); } SEAM(2);
    if (IN(3)) for (int rep = 0; rep <= REP(3); ++rep) { if (rep) xcd_barrier(xbar);
        { SchedFH S{(const char*)(ws + WS_CS1024), (const char*)(ws + WS_R1 + R1_PQT), G, c};
          EpiSplitK E{R2, D, 512, (float*)(ws + WS_R3), (unsigned*)(ws + WS_BAR) + XCD_BAR_WORDS + 512, (unsigned*)(ws + WS_BAR)}; pg8::gemm_phase(lds, 1024, S, E, 2048); }
        { SchedFL S{(const char*)(ws + WS_CS256), (const char*)(ws + WS_R1 + R1_PQT), G, c}; EpiPlain E{R2, D, 512}; pg8::gemm_phase(lds, 512, S, E); }
        const int nfree = G - 128; const int vb = (G - 1) - c;
        if (vb < nfree) { const int lo = vb < 64 ? 5 * vb : 320 + 3 * (vb - 64), hi = lo + (vb < 64 ? 5 : 3);
            for (int id = lo; id < hi; ++id)
                gmlp_item(lds, id, P.in[13], P.in[14], P.in[15], (const bf16_t*)(ws + WS_R1 + R1_U), (const bf16_t*)(ws + WS_R1 + R1_VT0), R2, tid, id == lo || (id & 3) == 0); }
        if (rep == 0 && vb < nfree) tr_run(P, ws, (LAS float*)lds, 1, vb, nfree, tid);
    } SEAM(3);
    if (IN(4)) { SchedNat S{(const char*)R2, (const char*)(ws + WS_WOUT), D, 4, G, c};
        EpiResNorm<true> E{P.in[0], P.in[1], nullptr, X, H, MOD + 2 * 1024, P.in[9], P.in[10], MOD + 3 * 1024, MOD + 4 * 1024,
            (float*)(ws + WS_SLOTS) + 1 * 65536, (float*)(ws + WS_SLOTS) + 2 * 65536, (unsigned*)(ws + WS_BAR) + XCD_BAR_WORDS + 64 * 1, (unsigned*)(ws + WS_BAR) + XCD_BAR_WORDS + 64 * 2, (unsigned*)(ws + WS_BAR)};
        pg8::gemm_phase(lds, D, S, E); } GSEAM(4, 6, 0);
    if (IN(6)) for (int rep = 0; rep <= REP(6); ++rep) { if (rep) xcd_barrier(xbar); SchedNat S{(const char*)H, (const char*)(ws + WS_WGU), D, 22, G, c}; EpiSwiGLU E{HF}; pg8::gemm_phase(lds, D, S, E);
        if (rep == 0 && c >= 128) { tr_run(P, ws, (LAS float*)lds, 2, c - 128, G - 128, tid);
            asm volatile("s_waitcnt vmcnt(0)" ::: "memory"); __syncthreads();
            if (tid == 0) (void)xb_add((unsigned*)(ws + WS_BAR) + XB_TRCNT, 1u); }
    } GSEAM(6, 7, 1);
    if (IN(7)) { SchedNat S{(const char*)HF, (const char*)(ws + WS_WDN), DFF, 4, G, c};
        EpiResNorm<false> E{nullptr, nullptr, X, X, H, MOD + 5 * 1024, P.in[11], P.in[8] + 1024, MOD + 9 * 6144 + 0 * 1024, MOD + 9 * 6144 + 1 * 1024,
            (float*)(ws + WS_SLOTS) + 3 * 65536, (float*)(ws + WS_SLOTS) + 4 * 65536, (unsigned*)(ws + WS_BAR) + XCD_BAR_WORDS + 64 * 3, (unsigned*)(ws + WS_BAR) + XCD_BAR_WORDS + 64 * 4, (unsigned*)(ws + WS_BAR)};
        pg8::gemm_phase(lds, DFF, S, E); }
    if (IN(7) && IN(9)) grp_sync((unsigned*)(ws + WS_BAR) + XCD_BAR_WORDS + 1024 + (6 * 64 + (c & 31)) * 4, (unsigned*)(ws + WS_BAR), 8u);
    if (IN(9)) {
        if (IN(6)) {
            if (tid == 0) { unsigned* bw = (unsigned*)(ws + WS_BAR); XB_SPIN(xb_ld(bw + XB_TRCNT) < (unsigned)(G - 128), bw); __builtin_amdgcn_fence(__ATOMIC_ACQUIRE, "agent"); asm volatile("s_waitcnt vmcnt(0)" ::: "memory"); }
            __syncthreads(); }
        EpiQKV E{(bf16_t*)(ws + WS_Q), (bf16_t*)(ws + WS_K1), (bf16_t*)(ws + WS_VT1), P.out + (size_t)2 * NP * D, P.out + (size_t)2 * NP * D + (size_t)NP * 256, (const float*)(ws + WS_ROPE)};
        { SchedQKV S{(const char*)H, (const char*)(ws + WS_WQKV), G, c, 0}; pg8::gemm_phase(lds, D, S, E); }
        grp_sync((unsigned*)(ws + WS_BAR) + XCD_BAR_WORDS + 1024 + (7 * 64 + (c & 31)) * 4, (unsigned*)(ws + WS_BAR), 8u);
        { SchedQKV S{(const char*)H, (const char*)(ws + WS_WQKV), G, c, 1}; pg8::gemm_phase(lds, D, S, E); }
        const int cb = G > 128 ? c - 128 : c, cs = G > 128 ? G - 128 : G;
        if (cb >= 0) for (int it = 256 + cb; it < 512; it += cs)
            attn_item(lds, it, (const bf16_t*)(ws + WS_Q), (const bf16_t*)(ws + WS_K1), (const bf16_t*)(ws + WS_VT1), (const bf16_t*)(ws + WS_CK), (const bf16_t*)(ws + WS_CVT), P.in[18], R2, tid);
    }
    if (IN(9) && IN(10)) {
        unsigned* bw = (unsigned*)(ws + WS_BAR); const int bb = (c & 31) >> 2, kq = c >> 5;
        asm volatile("s_waitcnt vmcnt(0)" ::: "memory"); __syncthreads();
        if (tid == 0 && (kq == 2 || kq == 3)) (void)xb_add(bw + XB_KVCNT + bb, 1u);
        grp_sync(bw + XCD_BAR_WORDS + 1024 + (8 * 64 + (c & 31)) * 4, bw, 8u);
        if (tid == 0) { XB_SPIN(xb_ld(bw + XB_KVCNT + bb) < 8u, bw); __builtin_amdgcn_fence(__ATOMIC_ACQUIRE, "agent"); asm volatile("s_waitcnt vmcnt(0)" ::: "memory"); }
        __syncthreads();
    }
    if (IN(10)) { for (int cc = c; cc < 256; cc += G) { const int t5 = cc & 31, it = (t5 >> 2) * 32 + (cc >> 5) * 4 + (t5 & 3);
            attn_item(lds, it, (const bf16_t*)(ws + WS_Q), (const bf16_t*)(ws + WS_K1), (const bf16_t*)(ws + WS_VT1), (const bf16_t*)(ws + WS_CK), (const bf16_t*)(ws + WS_CVT), P.in[18], R2, tid); } }
    if (IN(10) && IN(11)) grp_sync((unsigned*)(ws + WS_BAR) + XCD_BAR_WORDS + 1024 + (5 * 64 + (c & 31)) * 4, (unsigned*)(ws + WS_BAR), 8u);
    if (IN(11)) { SchedNat S{(const char*)R2, (const char*)(ws + WS_WO), D, 4, G, c};
        EpiResNorm<false> E{nullptr, nullptr, X, X, H, MOD + 9 * 6144 + 2 * 1024, P.in[9] + 1024, P.in[10] + 1024, MOD + 9 * 6144 + 3 * 1024, MOD + 9 * 6144 + 4 * 1024,
            (float*)(ws + WS_SLOTS) + 5 * 65536, (float*)(ws + WS_SLOTS) + 6 * 65536, (unsigned*)(ws + WS_BAR) + XCD_BAR_WORDS + 64 * 5, (unsigned*)(ws + WS_BAR) + XCD_BAR_WORDS + 64 * 6, (unsigned*)(ws + WS_BAR)};
        pg8::gemm_phase(lds, D, S, E); } GSEAM(11, 13, 2);
    if (IN(13)) { SchedNat S{(const char*)H, (const char*)(ws + WS_WGU + (size_t)5632 * D * 2), D, 22, G, c}; EpiSwiGLU E{HF}; pg8::gemm_phase(lds, D, S, E); } GSEAM(13, 14, 3);
    if (IN(14)) { SchedNat S{(const char*)HF, (const char*)(ws + WS_WDN + (size_t)1024 * DFF * 2), DFF, 4, G, c};
        EpiFinal E{X, P.out, MOD + 9 * 6144 + 5 * 1024, P.in[11] + 1024, (float*)(ws + WS_SLOTS), (unsigned*)(ws + WS_BAR) + XCD_BAR_WORDS, (unsigned*)(ws + WS_BAR)};
        pg8::gemm_phase(lds, DFF, S, E); }
#undef IN
#undef SEAM
}

extern "C" void kernel_launch(void* const* d_in, const int* in_sizes, int n_in, void* d_out, int out_size, void* d_ws, size_t ws_size, hipStream_t stream) {
    static int grid = 0;
    if (grid == 0) {
        if (n_in != 23 || ws_size < WS_END) { fprintf(stderr, "kernel_launch: unexpected inputs (n_in %d, ws %zu)\n", n_in, ws_size); grid = -1; return; }
        int dev = 0, cus = 0, per_cu = 0;
        hipGetDevice(&dev);
        hipDeviceGetAttribute(&cus, hipDeviceAttributeMultiprocessorCount, dev);
        if (hipFuncSetAttribute((const void*)fwd_kernel, hipFuncAttributeMaxDynamicSharedMemorySize, LDS_BYTES) != hipSuccess) { fprintf(stderr, "kernel_launch: hipFuncSetAttribute failed\n"); grid = -1; return; }
        hipOccupancyMaxActiveBlocksPerMultiprocessor(&per_cu, (const void*)fwd_kernel, 512, LDS_BYTES);
        (void)hipGetLastError();
        if (per_cu < 1) per_cu = 1;
        if (cus < 256) { fprintf(stderr, "kernel_launch: built for a 256-CU device (got %d CUs)\n", cus); grid = -1; return; }
        grid = 256;
        fprintf(stderr, "kernel_launch: cus %d per_cu %d grid %d\n", cus, per_cu, grid);
    }
    if (grid < 0) return;
    Params p{};
    for (int i = 0; i < 23; ++i) p.in[i] = (const float*)d_in[i];
    p.out = (float*)d_out; p.ws = (unsigned char*)d_ws;
#if MK_PER_PHASE
#ifndef HOST_REPEAT_MASK
#define HOST_REPEAT_MASK 0
#endif
    for (int ph = 0; ph < NPHASE; ++ph) for (int rep = 0; rep <= ((HOST_REPEAT_MASK >> ph) & 1); ++rep) { if (rep) (void)hipMemsetAsync((char*)d_ws + WS_STATS, 0, 4 * 16384 * 4, stream); p.ph_lo = ph; p.ph_hi = ph + 1; hipLaunchKernelGGL(fwd_kernel, dim3(grid), dim3(512), LDS_BYTES, stream, p); }
#else
    p.ph_lo = 0; p.ph_hi = NPHASE;
    if (hipMemsetAsync((char*)d_ws + WS_BAR, 0, (XCD_BAR_WORDS + 3328) * 4, stream) != hipSuccess) { fprintf(stderr, "kernel_launch: memset failed\n"); return; }
    void* args[] = {&p};
    hipError_t e = hipLaunchCooperativeKernel((const void*)fwd_kernel, dim3(grid), dim3(512), args, LDS_BYTES, stream);
    if (e != hipSuccess) fprintf(stderr, "cooperative launch failed: %s (grid %d)\n", hipGetErrorString(e), grid);
#endif
}
```

```cpp
#include <hip/hip_runtime.h>
#include <hip/hip_cooperative_groups.h>
#include <cstdio>
#include <cstdint>
namespace cg = cooperative_groups;

#ifndef MK_PER_PHASE
#define MK_PER_PHASE 0
#endif

#define LAS __attribute__((address_space(3)))
typedef unsigned short bf16_t;
typedef short bf16x8 __attribute__((ext_vector_type(8)));
typedef short bf16x4 __attribute__((ext_vector_type(4)));
typedef float f32x4 __attribute__((ext_vector_type(4)));
typedef unsigned u32x4 __attribute__((ext_vector_type(4)));
typedef unsigned u32x2 __attribute__((ext_vector_type(2)));

constexpr int NTOK = 16384, NP = 8192, D = 1024, DFF = 2816;
constexpr float EPS = 1e-6f;
constexpr float LOG2E = 1.4426950408889634f;
constexpr float QSCALE = 0.08838834764831845f * LOG2E;

constexpr size_t MiB = 1024 * 1024;
constexpr size_t WS_MOD = 0;
constexpr size_t WS_STATS = 512 * 1024;
constexpr size_t WS_BAR = 896 * 1024;
constexpr size_t WS_SLOTS = 236 * MiB;
constexpr size_t WS_CK = 1 * MiB;
constexpr size_t WS_CVT = 2 * MiB;
constexpr size_t WS_CS256 = 3 * MiB;
constexpr size_t WS_ROPE = 3 * MiB + 512 * 1024;
constexpr size_t WS_CS1024 = 4 * MiB;
constexpr size_t WS_WIN = 8 * MiB;
constexpr size_t WS_WOUT = 12 * MiB;
constexpr size_t WS_WQKV = 14 * MiB;
constexpr size_t WS_WO = 17 * MiB;
constexpr size_t WS_WGU = 19 * MiB;
constexpr size_t WS_WDN = 41 * MiB;
constexpr size_t WS_H = 52 * MiB;
constexpr size_t WS_R2 = WS_H;
constexpr size_t WS_X = 84 * MiB;
constexpr size_t WS_R3 = 116 * MiB;
constexpr size_t WS_R1 = 148 * MiB;
constexpr size_t WS_END = 256 * MiB;
constexpr size_t R1_U = 0, R1_VT0 = 16 * MiB, R1_PQT = 32 * MiB;
constexpr size_t WS_Q = WS_R3, WS_K1 = 240 * MiB, WS_VT1 = 248 * MiB;

constexpr int LDS_BYTES = 132 * 1024;
constexpr int NPHASE = 16;

__device__ __forceinline__ unsigned cvt_pk_bf16(float lo, float hi) { unsigned r; asm volatile("v_cvt_pk_bf16_f32 %0, %1, %2" : "=v"(r) : "v"(lo), "v"(hi)); return r; }
__device__ __forceinline__ float bf_lo(unsigned w) { return __uint_as_float(w << 16); }
__device__ __forceinline__ float bf_hi(unsigned w) { return __uint_as_float(w & 0xffff0000u); }
__device__ __forceinline__ float fast_rcp(float x) { return __builtin_amdgcn_rcpf(x); }
__device__ __forceinline__ float fast_exp2(float x) { return __builtin_amdgcn_exp2f(x); }
__device__ __forceinline__ float silu_f(float x) { return x * fast_rcp(1.0f + fast_exp2(-x * LOG2E)); }
typedef float f32x2 __attribute__((ext_vector_type(2)));
__device__ __forceinline__ f32x2 silu_mul_pk(f32x2 g, f32x2 u) {
    const f32x2 a = g * (-LOG2E); f32x2 e; e.x = fast_exp2(a.x); e.y = fast_exp2(a.y);
    const f32x2 d = e + 1.0f; f32x2 r; r.x = fast_rcp(d.x); r.y = fast_rcp(d.y);
    return (g * u) * r; }
__device__ __forceinline__ f32x2 gelu_pk(f32x2 x) {
    const f32x2 x2 = x * x, p = x2 * (0.044715f * -2.0f * LOG2E * 0.7978845608028654f) + (-2.0f * LOG2E * 0.7978845608028654f), a = x * p;
    f32x2 e; e.x = fast_exp2(a.x); e.y = fast_exp2(a.y);
    const f32x2 d = e + 1.0f; f32x2 r; r.x = fast_rcp(d.x); r.y = fast_rcp(d.y);
    return x * r; }
__device__ __forceinline__ f32x4 gelu_pk4(f32x4 v) { const f32x2 a = gelu_pk((f32x2){v[0], v[1]}), b = gelu_pk((f32x2){v[2], v[3]}); return (f32x4){a.x, a.y, b.x, b.y}; }
__device__ __forceinline__ float gelu_f(float x) { const float y = 0.7978845608028654f * (x + 0.044715f * x * x * x); return x * fast_rcp(1.0f + fast_exp2(-2.0f * LOG2E * y)); }
__device__ __forceinline__ float wave_sum(float v) {
    v += __shfl_xor(v, 1); v += __shfl_xor(v, 2); v += __shfl_xor(v, 4); v += __shfl_xor(v, 8); v += __shfl_xor(v, 16); v += __shfl_xor(v, 32); return v;
}


#define XB_TMO      128
#define XB_KVCNT    68
#define XB_TRCNT    66
#define XB_XCNT(j)  (256  + 64 * (j))
#define XB_XSUB(j)  (1280 + 64 * (j))
#define XB_XGEN(j)  (2304 + 64 * (j))
#define XB_TOP      3328
#define XB_TOPGEN   3392
#define XCD_BAR_WORDS 3456
#define XB_SPIN_CAP (1u << 20)
__device__ __forceinline__ unsigned xb_ld(unsigned* p)              { return __hip_atomic_load(p, __ATOMIC_RELAXED, __HIP_MEMORY_SCOPE_AGENT); }
__device__ __forceinline__ unsigned xb_add(unsigned* p, unsigned v) { return __hip_atomic_fetch_add(p, v, __ATOMIC_RELAXED, __HIP_MEMORY_SCOPE_AGENT); }
__device__ __forceinline__ unsigned xb_xcc_id() { return (unsigned)__builtin_amdgcn_s_getreg((3 << 11) | 20) & 0xFu; }
#define XB_SPIN(cond, bar) do { unsigned _sp = 0; while (cond) { __builtin_amdgcn_s_sleep(1); \
    if ((++_sp & 255u) == 0u) { if (xb_ld(&(bar)[XB_TMO])) break; if (_sp > XB_SPIN_CAP) { atomicAdd(&(bar)[XB_TMO], 1u); break; } } } } while (0)
struct XcdBarrier { unsigned* bar; unsigned x; volatile LAS unsigned* st; };
__device__ __forceinline__ XcdBarrier xcd_barrier_post(unsigned* bar, volatile LAS unsigned* st) {
    XcdBarrier b; b.bar = bar; b.x = xb_xcc_id(); b.st = st;
    if (threadIdx.x == 0) (void)xb_add(&bar[XB_XCNT(b.x)], 1u);
    return b;
}
__device__ __forceinline__ void xcd_barrier_complete(unsigned* bar, unsigned x, unsigned& nloc, unsigned& nx) {
    const unsigned G = gridDim.x * gridDim.y * gridDim.z;
    unsigned sum, cnt, mine, sp = 0u;
    for (;;) {
        sum = 0u; cnt = 0u; mine = 0u;
#pragma unroll
        for (unsigned j = 0; j < 16; ++j) { const unsigned c = xb_ld(&bar[XB_XCNT(j)]); sum += c; cnt += (c > 0u) ? 1u : 0u; mine = (j == x) ? c : mine; }
        if (sum == G) break;
        __builtin_amdgcn_s_sleep(1);
        if ((++sp & 255u) == 0u) { if (xb_ld(&bar[XB_TMO])) break; if (sp > XB_SPIN_CAP) { atomicAdd(&bar[XB_TMO], 1u); break; } }
    }
    nloc = mine > 0u ? mine : 1u; nx = cnt > 0u ? cnt : 1u;
}
__device__ __forceinline__ void xcd_barrier(const XcdBarrier& b) {
    asm volatile("s_waitcnt vmcnt(0)" ::: "memory");
    __syncthreads();
    if (threadIdx.x == 0) {
        unsigned* bar = b.bar;
        __builtin_amdgcn_s_waitcnt(0);
        unsigned nloc = b.st[0], nx = b.st[1];
        if (nloc == 0u) { xcd_barrier_complete(bar, b.x, nloc, nx); b.st[0] = nloc; b.st[1] = nx; }
        const unsigned old = xb_add(&bar[XB_XSUB(b.x)], 1u);
        const unsigned gen = old / nloc;
        if (old + 1u == (gen + 1u) * nloc) {
            __builtin_amdgcn_fence(__ATOMIC_RELEASE, "agent");
            asm volatile("s_waitcnt vmcnt(0)" ::: "memory");
            const unsigned og = xb_add(&bar[XB_TOP], 1u);
            const unsigned tg = og / nx;
            if (og + 1u == (tg + 1u) * nx) xb_add(&bar[XB_TOPGEN], 1u);
            else XB_SPIN(xb_ld(&bar[XB_TOPGEN]) == tg, bar);
            __builtin_amdgcn_fence(__ATOMIC_ACQUIRE, "agent");
            xb_add(&bar[XB_XGEN(b.x)], 1u);
            asm volatile("s_waitcnt vmcnt(0)" ::: "memory");
        } else {
            XB_SPIN(xb_ld(&bar[XB_XGEN(b.x)]) == gen, bar);
            __builtin_amdgcn_fence(__ATOMIC_ACQUIRE, "agent");
            asm volatile("s_waitcnt vmcnt(0)" ::: "memory");
        }
    }
    __syncthreads();
}

__device__ __forceinline__ void grp_sync(unsigned* w, unsigned* bar, const unsigned need = 4u) {
    asm volatile("s_waitcnt vmcnt(0)" ::: "memory");
    __syncthreads();
    if (threadIdx.x == 0) {
        const unsigned x = xb_xcc_id();
        unsigned long long* aw = (unsigned long long*)w;
        (void)__hip_atomic_fetch_add(aw, 1ull << (4u * x), __ATOMIC_RELAXED, __HIP_MEMORY_SCOPE_AGENT);
        unsigned long long v; unsigned sum; unsigned sp = 0u;
        for (;;) { v = __hip_atomic_load(aw, __ATOMIC_RELAXED, __HIP_MEMORY_SCOPE_AGENT); sum = 0u;
#pragma unroll
            for (int j = 0; j < 16; ++j) sum += (unsigned)(v >> (4 * j)) & 15u;
            if (sum >= need) break;
            __builtin_amdgcn_s_sleep(1);
            if ((++sp & 255u) == 0u) { if (xb_ld(&bar[XB_TMO])) break; if (sp > XB_SPIN_CAP) { atomicAdd(&bar[XB_TMO], 1u); break; } } }
        if (((unsigned)(v >> (4u * x)) & 15u) != need) {
            __builtin_amdgcn_fence(__ATOMIC_RELEASE, "agent");
            asm volatile("s_waitcnt vmcnt(0)" ::: "memory");
            (void)xb_add(w + 2, 1u); XB_SPIN(xb_ld(w + 2) < need, bar); }
        __builtin_amdgcn_fence(__ATOMIC_ACQUIRE, "agent");
        asm volatile("s_waitcnt vmcnt(0)" ::: "memory");
    }
    __syncthreads();
}

namespace pg8 {
constexpr int BM = 256, BK = 64, HALF = 128, HTB = HALF * BK * 2, STAGE_BYTES = 8 * HTB;
__host__ __device__ __forceinline__ int lds_byte(int r, int c) { const int st = (r >> 4) * 2 + (c >> 5), rr = r & 15, cc = c & 31, ob = rr * 64 + cc * 2; return st * 1024 + (ob ^ (((ob >> 9) & 1) << 5)); }
__host__ __device__ __forceinline__ void stage_rc(int b, int& R, int& C) { const int st = b / 1024, sb = b % 1024, swz = sb ^ (((sb >> 9) & 1) << 5); R = (st >> 1) * 16 + swz / 64; C = (st & 1) * 32 + (swz % 64) / 2; }
__host__ __device__ __forceinline__ int perm32(int rho) { const int n = rho >> 4, i = rho & 15; return 8 * (i >> 2) + 4 * n + (i & 3); }

struct Unit { int pm, pn, kind, pad; const char* a; const char* b; };

template <class Epi, class Sched>
__device__ __forceinline__ void gemm_phase(LAS unsigned char* lds, const int K, const Sched& S, const Epi& E, const int pitch_ = 0) {
    const int tid = threadIdx.x, wid = __builtin_amdgcn_readfirstlane(tid >> 6), lane = tid & 63, wr = wid >> 2, wc = wid & 3, fr = lane & 15, fq = lane >> 4;
    const int nt = K / BK, pitch = pitch_ ? pitch_ : K;
    unsigned voffA[2], voffB[2];
#pragma unroll
    for (int i = 0; i < 2; ++i) { int R, C; stage_rc(tid * 16 + i * 8192, R, C); const int Rb = Epi::PERM ? ((R & ~31) + perm32(R & 31)) : R;
        voffA[i] = (unsigned)(R * pitch + C) * 2u; voffB[i] = (unsigned)(Rb * pitch + C) * 2u; }
    const size_t kstep = (size_t)(BK * 2);
    const size_t hstep = (size_t)HALF * pitch * 2;
    const unsigned ldsw = (unsigned)wid * 1024u;
    const int aoff = lds_byte(wr * 64 + fr, fq * 8), boff = lds_byte(wc * 32 + fr, fq * 8);
#define PG8_SA(b, h) (((b) * 2 + (h)) * HTB)
#define PG8_SB(b, h) ((4 + (b) * 2 + (h)) * HTB)
#define PG8_STAGE(bufoff, gbase, voff) do { _Pragma("unroll") for (int _i = 0; _i < 2; ++_i) \
        __builtin_amdgcn_global_load_lds((const unsigned*)((const char*)(gbase) + (voff)[_i]), (LAS unsigned*)(lds + (bufoff) + ldsw + _i * 8192), 16, 0, 0); } while (0)
#define PG8_LDA(dst, b, h) do { _Pragma("unroll") for (int m = 0; m < 4; ++m) _Pragma("unroll") for (int k = 0; k < 2; ++k) dst[m][k] = *(const LAS bf16x8*)(lds + PG8_SA(b, h) + aoff + m * 2048 + k * 1024); } while (0)
#define PG8_LDB(dst, b, h) do { _Pragma("unroll") for (int n = 0; n < 2; ++n) _Pragma("unroll") for (int k = 0; k < 2; ++k) dst[n][k] = *(const LAS bf16x8*)(lds + PG8_SB(b, h) + boff + n * 2048 + k * 1024); } while (0)
#define PG8_MMA(ai, bj, At, Bt) do { __builtin_amdgcn_s_setprio(1); _Pragma("unroll") for (int m = 0; m < 4; ++m) _Pragma("unroll") for (int n = 0; n < 2; ++n) _Pragma("unroll") for (int k = 0; k < 2; ++k) \
        acc[ai][bj][m][n] = __builtin_amdgcn_mfma_f32_16x16x32_bf16(Bt[n][k], At[m][k], acc[ai][bj][m][n], 0, 0, 0); __builtin_amdgcn_s_setprio(0); } while (0)
#define PG8_WAIT_V(n) asm volatile("s_waitcnt vmcnt(" #n ")" ::: "memory")
#define PG8_WAIT_L(n) asm volatile("s_waitcnt lgkmcnt(" #n ")" ::: "memory")
#define PG8_BAR __builtin_amdgcn_s_barrier()
#define PG8_SCHED __builtin_amdgcn_sched_barrier(0)
    Unit cur, nxt; int ui = 0;
    if (!S.next(0, cur)) return;
    f32x4 acc[2][2][4][2];
#pragma unroll
    for (int a = 0; a < 2; ++a)
#pragma unroll
        for (int b = 0; b < 2; ++b)
#pragma unroll
            for (int m = 0; m < 4; ++m)
#pragma unroll
                for (int n = 0; n < 2; ++n) acc[a][b][m][n] = (f32x4){0.f, 0.f, 0.f, 0.f};
    bf16x8 At[4][2], B0[2][2], B1[2][2];
    const char* cA = cur.a; const char* cB = cur.b;
    PG8_STAGE(PG8_SB(0, 0), cB, voffB); PG8_STAGE(PG8_SB(0, 1), cB + hstep, voffB); PG8_STAGE(PG8_SA(0, 0), cA, voffA); PG8_STAGE(PG8_SA(0, 1), cA + hstep, voffA);
    if (wr == 1) PG8_BAR;
    PG8_WAIT_V(2); PG8_BAR;
    PG8_STAGE(PG8_SB(1, 0), cB + kstep, voffB); PG8_STAGE(PG8_SA(1, 0), cA + kstep, voffA); PG8_STAGE(PG8_SB(1, 1), cB + hstep + kstep, voffB);
    PG8_WAIT_V(6); PG8_BAR;
    for (;;) {
        const bool has_next = S.next(ui + 1, nxt);
        const char* nA = has_next ? nxt.a : cA; const char* nB = has_next ? nxt.b : cB;
        for (int t = 0; t < nt; t += 2) {
            const bool last = (t == nt - 2);
            const char* a1 = cA + (size_t)(t + 1) * kstep;
            const char* a2 = last ? nA : cA + (size_t)(t + 2) * kstep; const char* b2 = last ? nB : cB + (size_t)(t + 2) * kstep;
            const char* a3 = a2 + kstep; const char* b3 = b2 + kstep;
            PG8_LDB(B0, 0, 0); PG8_LDB(B1, 0, 1); PG8_SCHED; PG8_LDA(At, 0, 0); PG8_STAGE(PG8_SA(1, 1), a1 + hstep, voffA);
            PG8_WAIT_V(8); PG8_WAIT_L(0); PG8_BAR; PG8_MMA(0, 0, At, B0); PG8_MMA(0, 1, At, B1); PG8_BAR; PG8_SCHED;
            PG8_LDA(At, 0, 1); PG8_STAGE(PG8_SB(0, 0), b2, voffB); PG8_STAGE(PG8_SB(0, 1), b2 + hstep, voffB); PG8_STAGE(PG8_SA(0, 0), a2, voffA);
            PG8_WAIT_V(8); PG8_WAIT_L(0); PG8_BAR; PG8_MMA(1, 0, At, B0); PG8_MMA(1, 1, At, B1); PG8_BAR; PG8_SCHED;
            PG8_LDB(B0, 1, 0); PG8_LDB(B1, 1, 1); PG8_SCHED; PG8_LDA(At, 1, 0); PG8_STAGE(PG8_SA(0, 1), a2 + hstep, voffA);
            PG8_WAIT_V(8); PG8_WAIT_L(0); PG8_BAR; PG8_MMA(0, 0, At, B0); PG8_MMA(0, 1, At, B1); PG8_BAR; PG8_SCHED;
            PG8_LDA(At, 1, 1); PG8_STAGE(PG8_SB(1, 0), b3, voffB); PG8_STAGE(PG8_SB(1, 1), b3 + hstep, voffB); PG8_STAGE(PG8_SA(1, 0), a3, voffA);
            PG8_WAIT_V(8); PG8_WAIT_L(0); PG8_BAR; PG8_MMA(1, 0, At, B0); PG8_MMA(1, 1, At, B1); PG8_BAR; PG8_SCHED;
        }
        if (wr == 0) PG8_BAR;
        { int efr = fr, efq = fq; asm volatile("" : "+v"(efr), "+v"(efq));
          if constexpr (!Epi::AFTER_DRAIN) E(acc, cur, wr, wc, efr, efq); }
        if (!has_next) break;
#pragma unroll
        for (int a = 0; a < 2; ++a)
#pragma unroll
            for (int b = 0; b < 2; ++b)
#pragma unroll
                for (int m = 0; m < 4; ++m)
#pragma unroll
                    for (int n = 0; n < 2; ++n) acc[a][b][m][n] = (f32x4){0.f, 0.f, 0.f, 0.f};
        cur = nxt; cA = nA; cB = nB; ++ui;
        if (wr == 1) PG8_BAR;
    }
    PG8_WAIT_V(0);
    PG8_BAR;
    if constexpr (Epi::AFTER_DRAIN) { int efr = fr, efq = fq; asm volatile("" : "+v"(efr), "+v"(efq)); E.fused(acc, cur, wr, wc, efr, efq, lds, wid, lane); }
#undef PG8_SA
#undef PG8_SB
#undef PG8_STAGE
#undef PG8_LDA
#undef PG8_LDB
#undef PG8_MMA
#undef PG8_WAIT_V
#undef PG8_WAIT_L
#undef PG8_BAR
#undef PG8_SCHED
}
}
using pg8::Unit;
typedef f32x4 Acc[2][2][4][2];

__device__ __forceinline__ u32x4 pack8(const f32x4 v0, const f32x4 v1) { u32x4 w; w.x = cvt_pk_bf16(v0[0], v0[1]); w.y = cvt_pk_bf16(v0[2], v0[3]); w.z = cvt_pk_bf16(v1[0], v1[1]); w.w = cvt_pk_bf16(v1[2], v1[3]); return w; }

struct EpiL0 {
    static constexpr bool PERM = true, AFTER_DRAIN = false;
    bf16_t* U; bf16_t* VT; bf16_t* PQT;
    __device__ __forceinline__ void operator()(Acc& acc, const Unit& u, int wr, int wc, int fr, int fq) const {
        if (u.kind == 0) {
            const int row0 = u.pm * 256 + wr * 64 + fr, col0 = u.pn * 256 + wc * 32 + 8 * fq;
#pragma unroll
            for (int ai = 0; ai < 2; ++ai)
#pragma unroll
                for (int m = 0; m < 4; ++m) { bf16_t* rowp = U + (size_t)(row0 + ai * 128 + m * 16) * 512 + col0;
#pragma unroll
                    for (int bj = 0; bj < 2; ++bj) { f32x4 v0 = acc[ai][bj][m][0], v1 = acc[ai][bj][m][1];
#pragma unroll
                        for (int e = 0; e < 1; ++e) { v0 = gelu_pk4(v0); v1 = gelu_pk4(v1); }
                        *(u32x4*)(rowp + bj * 128) = pack8(v0, v1); } }
        } else if (u.pm < 2) {
            const int ch0 = u.pm * 256 + wr * 64 + fr, tok0 = u.pn * 256 + wc * 32 + 8 * fq;
#pragma unroll
            for (int ai = 0; ai < 2; ++ai)
#pragma unroll
                for (int m = 0; m < 4; ++m) { bf16_t* rowp = VT + (size_t)(ch0 + ai * 128 + m * 16) * NTOK + tok0;
#pragma unroll
                    for (int bj = 0; bj < 2; ++bj) {
#pragma unroll
                        for (int e = 0; e < 1; ++e) { acc[ai][bj][m][0] = gelu_pk4(acc[ai][bj][m][0]); acc[ai][bj][m][1] = gelu_pk4(acc[ai][bj][m][1]); }
                        *(u32x4*)(rowp + bj * 128) = pack8(acc[ai][bj][m][0], acc[ai][bj][m][1]); } }
        } else {
            const int chq = (u.pm - 2) * 256 + wr * 64 + fr;
            size_t base; int T, t0;
            if (u.pn < 32) { base = (size_t)u.pn * 262144; T = 256; t0 = 0; } else { base = (size_t)8388608 + (size_t)((u.pn - 32) >> 2) * 1048576; T = 1024; t0 = ((u.pn - 32) & 3) * 256; }
            const int tl = t0 + wc * 32 + 8 * fq;
#pragma unroll
            for (int ai = 0; ai < 2; ++ai)
#pragma unroll
                for (int m = 0; m < 4; ++m) { const int cq = chq + ai * 128 + m * 16, isq = cq >> 9, ch = cq & 511;
                    bf16_t* rowp = PQT + base + (size_t)ch * (2 * T) + isq * T + tl;
#pragma unroll
                    for (int bj = 0; bj < 2; ++bj) *(u32x4*)(rowp + bj * 128) = pack8(acc[ai][bj][m][0], acc[ai][bj][m][1]); }
        }
    }
};

struct EpiPlain {
    static constexpr bool PERM = true, AFTER_DRAIN = false;
    bf16_t* O; int ldc, coff;
    __device__ __forceinline__ void operator()(Acc& acc, const Unit& u, int wr, int wc, int fr, int fq) const {
        const int row0 = u.pm * 256 + wr * 64 + fr, col0 = coff + u.pn * 256 + wc * 32 + 8 * fq;
#pragma unroll
        for (int ai = 0; ai < 2; ++ai)
#pragma unroll
            for (int m = 0; m < 4; ++m) { bf16_t* rowp = O + (size_t)(row0 + ai * 128 + m * 16) * ldc + col0;
#pragma unroll
                for (int bj = 0; bj < 2; ++bj) *(u32x4*)(rowp + bj * 128) = pack8(acc[ai][bj][m][0], acc[ai][bj][m][1]); }
    }
};

struct EpiOutSS {
    static constexpr bool PERM = true, AFTER_DRAIN = false;
    bf16_t* O; float* rowss;
    __device__ __forceinline__ void operator()(Acc& acc, const Unit& u, int wr, int wc, int fr, int fq) const {
        const int row0 = u.pm * 256 + wr * 64 + fr, col0 = u.pn * 256 + wc * 32 + 8 * fq;
#pragma unroll
        for (int ai = 0; ai < 2; ++ai)
#pragma unroll
            for (int m = 0; m < 4; ++m) { const int row = row0 + ai * 128 + m * 16; bf16_t* rowp = O + (size_t)row * D + col0; float ss = 0.f;
#pragma unroll
                for (int bj = 0; bj < 2; ++bj) { const f32x4 v0 = acc[ai][bj][m][0], v1 = acc[ai][bj][m][1];
                    ss += (v0[0] * v0[0] + v0[1] * v0[1]) + (v0[2] * v0[2] + v0[3] * v0[3]) + (v1[0] * v1[0] + v1[1] * v1[1]) + (v1[2] * v1[2] + v1[3] * v1[3]);
                    *(u32x4*)(rowp + bj * 128) = pack8(v0, v1); }
                ss += __shfl_xor(ss, 16); ss += __shfl_xor(ss, 32);
                if (fq == 0) atomicAdd(rowss + row, ss); }
    }
};

struct EpiSwiGLU {
    static constexpr bool PERM = true, AFTER_DRAIN = false;
    bf16_t* HF;
    __device__ __forceinline__ void operator()(Acc& acc, const Unit& u, int wr, int wc, int fr, int fq) const {
        const int row0 = u.pm * 256 + wr * 64 + fr, col0 = u.pn * 128 + wc * 32 + 8 * fq;
#pragma unroll
        for (int ai = 0; ai < 2; ++ai)
#pragma unroll
            for (int m = 0; m < 4; ++m) { bf16_t* rowp = HF + (size_t)(row0 + ai * 128 + m * 16) * DFF + col0;
                f32x4 v0, v1;
#pragma unroll
                for (int e = 0; e < 4; e += 2) { const f32x2 a0 = silu_mul_pk((f32x2){acc[ai][0][m][0][e], acc[ai][0][m][0][e + 1]}, (f32x2){acc[ai][1][m][0][e], acc[ai][1][m][0][e + 1]});
                    const f32x2 a1 = silu_mul_pk((f32x2){acc[ai][0][m][1][e], acc[ai][0][m][1][e + 1]}, (f32x2){acc[ai][1][m][1][e], acc[ai][1][m][1][e + 1]});
                    v0[e] = a0.x; v0[e + 1] = a0.y; v1[e] = a1.x; v1[e + 1] = a1.y; }
                *(u32x4*)rowp = pack8(v0, v1); }
    }
};

struct EpiQKV {
    static constexpr bool PERM = true, AFTER_DRAIN = false;
    bf16_t* Q; bf16_t* Kb; bf16_t* VT; float* state_k; float* state_v; const float* rope;
    __device__ __forceinline__ void operator()(Acc& acc, const Unit& u, int wr, int wc, int fr, int fq) const {
        if (u.kind == 0) {
            const int row0 = u.pm * 256 + wr * 64 + fr;
            const int d0 = (wc >> 1) * 64 + (wc & 1) * 16 + fq * 4;
            const int i0 = (wc & 1) * 16 + fq * 4;
            const bool isq = u.pn < 4, latent = u.pm >= 32;
#pragma unroll
            for (int ai = 0; ai < 2; ++ai)
#pragma unroll
                for (int m = 0; m < 4; ++m) { const int row = row0 + ai * 128 + m * 16;
                    f32x4 cs = (f32x4){1.f, 1.f, 1.f, 1.f}, sn = (f32x4){0.f, 0.f, 0.f, 0.f};
                    if (latent) { const int t = (row - NP) & 1023; const float* rp = rope + (size_t)t * 64 + (wc >> 1) * 32 + i0; cs = *(const f32x4*)rp; sn = *(const f32x4*)(rp + 65536); }
#pragma unroll
                    for (int bj = 0; bj < 2; ++bj) { const f32x4 x0 = acc[ai][bj][m][0], x1 = acc[ai][bj][m][1]; f32x4 y0, y1;
#pragma unroll
                        for (int e = 0; e < 4; ++e) { y0[e] = x0[e] * cs[e] - x1[e] * sn[e]; y1[e] = x1[e] * cs[e] + x0[e] * sn[e]; }
                        if (isq) { bf16_t* p = Q + (size_t)row * D + (u.pn * 2 + bj) * 128 + d0;
                            u32x2 w0, w1; w0.x = cvt_pk_bf16(y0[0] * QSCALE, y0[1] * QSCALE); w0.y = cvt_pk_bf16(y0[2] * QSCALE, y0[3] * QSCALE); w1.x = cvt_pk_bf16(y1[0] * QSCALE, y1[1] * QSCALE); w1.y = cvt_pk_bf16(y1[2] * QSCALE, y1[3] * QSCALE);
                            *(u32x2*)p = w0; *(u32x2*)(p + 32) = w1; }
                        else { bf16_t* p = Kb + (size_t)row * 256 + bj * 128 + d0;
                            u32x2 w0, w1; w0.x = cvt_pk_bf16(y0[0], y0[1]); w0.y = cvt_pk_bf16(y0[2], y0[3]); w1.x = cvt_pk_bf16(y1[0], y1[1]); w1.y = cvt_pk_bf16(y1[2], y1[3]);
                            __hip_atomic_store((unsigned long long*)p, __builtin_bit_cast(unsigned long long, w0), __ATOMIC_RELAXED, __HIP_MEMORY_SCOPE_AGENT);
                            __hip_atomic_store((unsigned long long*)(p + 32), __builtin_bit_cast(unsigned long long, w1), __ATOMIC_RELAXED, __HIP_MEMORY_SCOPE_AGENT);
                            if (!latent) { float* sp = state_k + (size_t)row * 256 + bj * 128 + d0; *(f32x4*)sp = x0; *(f32x4*)(sp + 32) = x1; } } } }
        } else {
            const int ch0 = wr * 64 + fr, tok0 = u.pn * 256 + wc * 32 + 8 * fq;
#pragma unroll
            for (int ai = 0; ai < 2; ++ai)
#pragma unroll
                for (int m = 0; m < 4; ++m) { const int ch = ch0 + ai * 128 + m * 16; const __amdgpu_buffer_rsrc_t vr = __builtin_amdgcn_make_buffer_rsrc((void*)VT, (short)0, 0x7ffff000, 0x00020000); const unsigned voff = (unsigned)(ch * NTOK + tok0) * 2u;
#pragma unroll
                    for (int bj = 0; bj < 2; ++bj) { const f32x4 v0 = acc[ai][bj][m][0], v1 = acc[ai][bj][m][1];
                        __builtin_amdgcn_raw_buffer_store_b128(pack8(v0, v1), vr, voff + bj * 256u, 0, 16);
                        if (u.pn < 32) { float* sp = state_v + (size_t)(tok0 + bj * 128) * 256 + ch;
#pragma unroll
                            for (int e = 0; e < 4; ++e) { sp[(size_t)e * 256] = v0[e]; sp[(size_t)(4 + e) * 256] = v1[e]; } } } }
        }
    }
};

struct EpiFinal {
    static constexpr bool PERM = true, AFTER_DRAIN = true;
    const bf16_t* X; float* Y; const float* gate; const float* gpost; float* slots; unsigned* cnt; unsigned* bar;
    __device__ __forceinline__ void operator()(Acc&, const Unit&, int, int, int, int) const {}
    __device__ __forceinline__ void fused(Acc& acc, const Unit& u, int wr, int wc, int fr, int fq, LAS unsigned char* lds, int wid, int lane) const {
        LAS float* Pl = (LAS float*)lds;
        LAS float* Sl = (LAS float*)(lds + 4096);
#pragma unroll
        for (int ai = 0; ai < 2; ++ai)
#pragma unroll
            for (int m = 0; m < 4; ++m) { float ss = 0.f;
#pragma unroll
                for (int bj = 0; bj < 2; ++bj) { const f32x4 v0 = acc[ai][bj][m][0], v1 = acc[ai][bj][m][1];
                    ss += (v0[0] * v0[0] + v0[1] * v0[1]) + (v0[2] * v0[2] + v0[3] * v0[3]) + (v1[0] * v1[0] + v1[1] * v1[1]) + (v1[2] * v1[2] + v1[3] * v1[3]); }
                ss += __shfl_xor(ss, 16); ss += __shfl_xor(ss, 32);
                if (fq == 0) Pl[(ai * 128 + wr * 64 + m * 16 + fr) * 4 + wc] = ss; }
        __syncthreads();
        const int t = wid * 64 + lane;
        float* myslots = slots + ((size_t)u.pm * 256) * 4;
        if (t < 256) { const float sp = (Pl[t * 4 + 0] + Pl[t * 4 + 1]) + (Pl[t * 4 + 2] + Pl[t * 4 + 3]);
            __hip_atomic_store(myslots + t * 4 + u.pn, sp, __ATOMIC_RELAXED, __HIP_MEMORY_SCOPE_AGENT); }
        asm volatile("s_waitcnt vmcnt(0)" ::: "memory");
        __syncthreads();
        if (t == 0) { (void)xb_add(cnt + u.pm, 1u); XB_SPIN(xb_ld(cnt + u.pm) < 4u, bar); __builtin_amdgcn_fence(__ATOMIC_ACQUIRE, "agent"); asm volatile("s_waitcnt vmcnt(0)" ::: "memory"); }
        __syncthreads();
        if (t < 256) { float sacc = 0.f;
#pragma unroll
            for (int j = 0; j < 4; ++j) sacc += __hip_atomic_load(myslots + t * 4 + j, __ATOMIC_RELAXED, __HIP_MEMORY_SCOPE_AGENT);
            Sl[t] = rsqrtf(sacc * (1.0f / 1024.0f) + EPS); }
        __syncthreads();
        const int mrow = u.pm < 32 ? 0 : 1 + ((u.pm - 32) >> 2);
        const int col0 = u.pn * 256 + wc * 32 + 8 * fq;
#pragma unroll
        for (int bj = 0; bj < 2; ++bj) { const int c = col0 + bj * 128;
            const f32x4 g0 = *(const f32x4*)(gate + (size_t)mrow * 6144 + c) * *(const f32x4*)(gpost + c), g1 = *(const f32x4*)(gate + (size_t)mrow * 6144 + c + 4) * *(const f32x4*)(gpost + c + 4);
#pragma unroll
            for (int ai = 0; ai < 2; ++ai)
#pragma unroll
                for (int m = 0; m < 4; ++m) { const int rl = ai * 128 + wr * 64 + m * 16 + fr; const size_t row = (size_t)u.pm * 256 + rl; const float al = Sl[rl];
                    const u32x4 xw = *(const u32x4*)(X + row * D + c);
                    f32x4 y0, y1; const f32x4 a0 = acc[ai][bj][m][0], a1 = acc[ai][bj][m][1];
                    y0[0] = bf_lo(xw.x) + g0[0] * (a0[0] * al); y0[1] = bf_hi(xw.x) + g0[1] * (a0[1] * al); y0[2] = bf_lo(xw.y) + g0[2] * (a0[2] * al); y0[3] = bf_hi(xw.y) + g0[3] * (a0[3] * al);
                    y1[0] = bf_lo(xw.z) + g1[0] * (a1[0] * al); y1[1] = bf_hi(xw.z) + g1[1] * (a1[1] * al); y1[2] = bf_lo(xw.w) + g1[2] * (a1[2] * al); y1[3] = bf_hi(xw.w) + g1[3] * (a1[3] * al);
                    *(f32x4*)(Y + row * D + c) = y0; *(f32x4*)(Y + row * D + c + 4) = y1; } }
    }
};

template <bool XF32>
struct EpiResNorm {
    static constexpr bool PERM = true, AFTER_DRAIN = true;
    const float* xa; const float* xb; const bf16_t* Xin; bf16_t* Xout; bf16_t* H;
    const float* gate; const float* gpost; const float* gpre; const float* shift; const float* scale;
    float* slots1; float* slots2; unsigned* cnt1; unsigned* cnt2; unsigned* bar;
    __device__ __forceinline__ void operator()(Acc&, const Unit&, int, int, int, int) const {}
    __device__ __forceinline__ void exchange(const float (&part)[2][4], float* slots, unsigned* cntp, const Unit& u, int wr, int wc, int fr, int fq, LAS float* Pl, LAS float* Sl, int t) const {
        if (fq == 0) {
#pragma unroll
            for (int ai = 0; ai < 2; ++ai)
#pragma unroll
                for (int m = 0; m < 4; ++m) Pl[(ai * 128 + wr * 64 + m * 16 + fr) * 4 + wc] = part[ai][m]; }
        __syncthreads();
        float* myslots = slots + ((size_t)u.pm * 256) * 4;
        if (t < 256) { const float sp = (Pl[t * 4 + 0] + Pl[t * 4 + 1]) + (Pl[t * 4 + 2] + Pl[t * 4 + 3]);
            __hip_atomic_store(myslots + t * 4 + u.pn, sp, __ATOMIC_RELAXED, __HIP_MEMORY_SCOPE_AGENT); }
        asm volatile("s_waitcnt vmcnt(0)" ::: "memory");
        __syncthreads();
        if (t == 0) { (void)xb_add(cntp + u.pm, 1u); XB_SPIN(xb_ld(cntp + u.pm) < 4u, bar); __builtin_amdgcn_fence(__ATOMIC_ACQUIRE, "agent"); asm volatile("s_waitcnt vmcnt(0)" ::: "memory"); }
        __syncthreads();
        if (t < 256) { float sacc = 0.f;
#pragma unroll
            for (int j = 0; j < 4; ++j) sacc += __hip_atomic_load(myslots + t * 4 + j, __ATOMIC_RELAXED, __HIP_MEMORY_SCOPE_AGENT);
            Sl[t] = rsqrtf(sacc * (1.0f / 1024.0f) + EPS); }
        __syncthreads();
    }
    __device__ __forceinline__ void fused(Acc& acc, const Unit& u, int wr, int wc, int fr, int fq, LAS unsigned char* lds, int wid, int lane) const {
        LAS float* Pl = (LAS float*)lds; LAS float* Sl = (LAS float*)(lds + 4096);
        const int t = wid * 64 + lane;
        float part[2][4];
#pragma unroll
        for (int ai = 0; ai < 2; ++ai)
#pragma unroll
            for (int m = 0; m < 4; ++m) { float ss = 0.f;
#pragma unroll
                for (int bj = 0; bj < 2; ++bj) { const f32x4 v0 = acc[ai][bj][m][0], v1 = acc[ai][bj][m][1];
                    ss += (v0[0] * v0[0] + v0[1] * v0[1]) + (v0[2] * v0[2] + v0[3] * v0[3]) + (v1[0] * v1[0] + v1[1] * v1[1]) + (v1[2] * v1[2] + v1[3] * v1[3]); }
                ss += __shfl_xor(ss, 16); ss += __shfl_xor(ss, 32); part[ai][m] = ss; }
        exchange(part, slots1, cnt1, u, wr, wc, fr, fq, Pl, Sl, t);
        const int mrow = u.pm < 32 ? 0 : 1 + ((u.pm - 32) >> 2);
        const int col0 = u.pn * 256 + wc * 32 + 8 * fq;
#pragma unroll
        for (int ai = 0; ai < 2; ++ai)
#pragma unroll
            for (int m = 0; m < 4; ++m) part[ai][m] = 0.f;
#pragma unroll
        for (int bj = 0; bj < 2; ++bj) { const int c = col0 + bj * 128;
            const f32x4 g0 = *(const f32x4*)(gate + (size_t)mrow * 6144 + c) * *(const f32x4*)(gpost + c), g1 = *(const f32x4*)(gate + (size_t)mrow * 6144 + c + 4) * *(const f32x4*)(gpost + c + 4);
#pragma unroll
            for (int ai = 0; ai < 2; ++ai)
#pragma unroll
                for (int m = 0; m < 4; ++m) { const int rl = ai * 128 + wr * 64 + m * 16 + fr; const size_t row = (size_t)u.pm * 256 + rl; const float al = Sl[rl];
                    f32x4 x0, x1;
                    if (XF32) { const float* xr = (row < (size_t)NP ? xa + row * D : xb + (row - NP) * D) + c; x0 = *(const f32x4*)xr; x1 = *(const f32x4*)(xr + 4); }
                    else { const u32x4 xw = *(const u32x4*)(Xin + row * D + c); x0 = (f32x4){bf_lo(xw.x), bf_hi(xw.x), bf_lo(xw.y), bf_hi(xw.y)}; x1 = (f32x4){bf_lo(xw.z), bf_hi(xw.z), bf_lo(xw.w), bf_hi(xw.w)}; }
                    x0 += g0 * (acc[ai][bj][m][0] * al); x1 += g1 * (acc[ai][bj][m][1] * al);
                    const u32x4 w = pack8(x0, x1);
                    *(u32x4*)(Xout + row * D + c) = w;
                    x0 = (f32x4){bf_lo(w.x), bf_hi(w.x), bf_lo(w.y), bf_hi(w.y)}; x1 = (f32x4){bf_lo(w.z), bf_hi(w.z), bf_lo(w.w), bf_hi(w.w)};
                    acc[ai][bj][m][0] = x0; acc[ai][bj][m][1] = x1;
                    part[ai][m] += (x0[0] * x0[0] + x0[1] * x0[1]) + (x0[2] * x0[2] + x0[3] * x0[3]) + (x1[0] * x1[0] + x1[1] * x1[1]) + (x1[2] * x1[2] + x1[3] * x1[3]); } }
#pragma unroll
        for (int ai = 0; ai < 2; ++ai)
#pragma unroll
            for (int m = 0; m < 4; ++m) { float ss = part[ai][m]; ss += __shfl_xor(ss, 16); ss += __shfl_xor(ss, 32); part[ai][m] = ss; }
        exchange(part, slots2, cnt2, u, wr, wc, fr, fq, Pl, Sl, t);
#pragma unroll
        for (int bj = 0; bj < 2; ++bj) { const int c = col0 + bj * 128;
            const f32x4 gs0 = *(const f32x4*)(gpre + c) * (*(const f32x4*)(scale + (size_t)mrow * 6144 + c) + 1.0f), gs1 = *(const f32x4*)(gpre + c + 4) * (*(const f32x4*)(scale + (size_t)mrow * 6144 + c + 4) + 1.0f);
            const f32x4 sh0 = *(const f32x4*)(shift + (size_t)mrow * 6144 + c), sh1 = *(const f32x4*)(shift + (size_t)mrow * 6144 + c + 4);
#pragma unroll
            for (int ai = 0; ai < 2; ++ai)
#pragma unroll
                for (int m = 0; m < 4; ++m) { const int rl = ai * 128 + wr * 64 + m * 16 + fr; const size_t row = (size_t)u.pm * 256 + rl; const float rs = Sl[rl];
                    const f32x4 h0 = (acc[ai][bj][m][0] * rs) * gs0 + sh0, h1 = (acc[ai][bj][m][1] * rs) * gs1 + sh1;
                    *(u32x4*)(H + row * D + c) = pack8(h0, h1); } }
    }
};

typedef __amdgpu_buffer_rsrc_t rsrc_t;
struct EpiSplitK {
    static constexpr bool PERM = true, AFTER_DRAIN = true;
    bf16_t* O; int ldc, coff; float* slab; unsigned* cnt; unsigned* bar;
    __device__ __forceinline__ void operator()(Acc&, const Unit&, int, int, int, int) const {}
    __device__ __forceinline__ void fused(Acc& acc, const Unit& u, int wr, int wc, int fr, int fq, LAS unsigned char* lds, int wid, int lane) const {
        const int t = wid * 64 + lane, own = u.kind;
        const rsrc_t rs = __builtin_amdgcn_make_buffer_rsrc((void*)(slab + (size_t)blockIdx.x * 32768), (short)0, 131072, 0x00020000);
#pragma unroll
        for (int bj = 0; bj < 2; ++bj)
#pragma unroll
            for (int m = 0; m < 4; ++m)
#pragma unroll
                for (int n = 0; n < 2; ++n) { const f32x4 v = own ? acc[0][bj][m][n] : acc[1][bj][m][n];
                    __builtin_amdgcn_raw_buffer_store_b128(__builtin_bit_cast(u32x4, v), rs, (unsigned)((((bj * 4 + m) * 2 + n) * 512 + t) * 16), 0, 16); }
        asm volatile("s_waitcnt vmcnt(0)" ::: "memory");
        __syncthreads();
        if (t == 0) { unsigned* p = cnt + (blockIdx.x < (unsigned)u.pad ? blockIdx.x : (unsigned)u.pad); (void)xb_add(p, 1u); XB_SPIN(xb_ld(p) < 2u, bar);
            __builtin_amdgcn_fence(__ATOMIC_ACQUIRE, "agent"); asm volatile("s_waitcnt vmcnt(0)" ::: "memory"); }
        __syncthreads();
        const float* ps = slab + (size_t)u.pad * 32768;
        const int row0 = u.pm * 256 + own * 128 + wr * 64 + fr, col0 = coff + u.pn * 256 + wc * 32 + 8 * fq;
#pragma unroll
        for (int m = 0; m < 4; ++m)
#pragma unroll
            for (int bj = 0; bj < 2; ++bj) { f32x4 v[2];
#pragma unroll
                for (int n = 0; n < 2; ++n) { const f32x4 pv = *(const f32x4*)(ps + (size_t)(((bj * 4 + m) * 2 + n) * 512 + t) * 4); v[n] = (own ? acc[1][bj][m][n] : acc[0][bj][m][n]) + pv; }
                *(u32x4*)(O + (size_t)(row0 + m * 16) * ldc + col0 + bj * 128) = pack8(v[0], v[1]); }
    }
};

struct SchedNat {
    const char* A; const char* B; int K, nN, G, c;
    __device__ __forceinline__ bool next(int i, Unit& u) const { const int L = i * G + c; if (L >= 64 * nN) return false;
        u.kind = 0; u.pad = 0; u.pm = L & 63; u.pn = L >> 6; u.a = A + (size_t)u.pm * 256 * K * 2; u.b = B + (size_t)u.pn * 256 * K * 2; return true; }
};
struct SchedL0 {
    const char* H; const char* W; int G, c;
    __device__ __forceinline__ bool next(int i, Unit& u) const { const int L = i * G + c; if (L >= 512) return false; u.pad = 0;
        if (L < 384) { u.kind = 1; u.pm = L >> 6; u.pn = L & 63; u.a = W + (size_t)(512 + u.pm * 256) * D * 2; u.b = H + (size_t)u.pn * 256 * D * 2; }
        else { const int l = L - 384; u.kind = 0; u.pm = l & 63; u.pn = l >> 6; u.a = H + (size_t)u.pm * 256 * D * 2; u.b = W + (size_t)u.pn * 256 * D * 2; } return true; }
};
struct SchedQKV {
    const char* H; const char* W; int G, c, part;
    __device__ __forceinline__ void nat(Unit& u, int pm, int pn) const { u.kind = 0; u.pm = pm; u.pn = pn; u.a = H + (size_t)pm * 256 * D * 2; u.b = W + (size_t)pn * 256 * D * 2; }
    __device__ __forceinline__ void swp(Unit& u, int tt) const { u.kind = 1; u.pm = 0; u.pn = tt; u.a = W + (size_t)1280 * D * 2; u.b = H + (size_t)tt * 256 * D * 2; }
    __device__ __forceinline__ bool next(int i, Unit& u) const { const int L = i * G + c; u.pad = 0;
        if (part == 0) { if (L >= 256) return false;
            if (L < 128) nat(u, L & 31, L >> 5); else if (L < 160) nat(u, L - 128, 4); else if (L < 192) swp(u, L - 160); else nat(u, 32 + ((L - 192) & 31), (L - 192) >> 5); }
        else { if (L >= 128) return false;
            if (L < 64) nat(u, 32 + (L & 31), 2 + (L >> 5)); else if (L < 96) nat(u, 32 + (L - 64), 4); else swp(u, 32 + (L - 96)); }
        return true; }
};
struct SchedFH {
    const char* CS; const char* PQ; int G, c;
    __device__ __forceinline__ bool next(int i, Unit& u) const { const int L = i * G + c; if (i > 0 || L >= 128) return false;
        const int id = L & 63, kh = L >> 6, sb = id >> 3, pt = (id >> 1) & 3, pn = id & 1; u.pm = 32 + sb * 4 + pt; u.pn = pn; u.kind = kh; u.pad = L ^ 64;
        u.a = CS + ((size_t)pt * 256 * 2048 + (size_t)kh * 1024) * 2; u.b = PQ + ((size_t)8388608 + (size_t)sb * 1048576 + (size_t)pn * 256 * 2048 + (size_t)kh * 1024) * 2; return true; }
};
struct SchedFL {
    const char* CS; const char* PQ; int G, c;
    __device__ __forceinline__ bool next(int i, Unit& u) const { int kmin = c >= 128 ? 0 : (128 - c + G - 1) / G; const int L = c + (kmin + i) * G - 128; if (L >= 64) return false; u.pad = 0; u.kind = 0;
        const int b = L >> 1, pn = L & 1; u.pm = b; u.pn = pn; u.a = CS; u.b = PQ + ((size_t)b * 262144 + (size_t)pn * 256 * 512) * 2; return true; }
};

struct Params { const float* in[23]; float* out; unsigned char* ws; int ph_lo, ph_hi; };

struct TrDesc { const float* src; bf16_t* dst; int ld, col0, k0, ldd, perm, pad; };
__device__ __forceinline__ void tr_load(const TrDesc& d, f32x4 (&v)[4], int tid) {
#pragma unroll
    for (int i = 0; i < 4; ++i) { const int kk = (tid >> 5) + 16 * i, c4 = (tid & 31) * 4; v[i] = *(const f32x4*)(d.src + (size_t)(d.k0 + kk) * d.ld + d.col0 + c4); }
}
__device__ __forceinline__ void tr_put(LAS float* tile, const f32x4 (&v)[4], int tid) {
#pragma unroll
    for (int i = 0; i < 4; ++i) { const int kk = (tid >> 5) + 16 * i, c4 = (tid & 31) * 4;
        tile[kk * 129 + c4] = v[i][0]; tile[kk * 129 + c4 + 1] = v[i][1]; tile[kk * 129 + c4 + 2] = v[i][2]; tile[kk * 129 + c4 + 3] = v[i][3]; }
}
__device__ __forceinline__ void tr_store(LAS float* tile, const TrDesc& d, int tid, bool wt) {
    const int j = tid >> 2, kq = tid & 3;
    int col = j;
    if (d.perm) { const int wc = j >> 5, fq = (j >> 3) & 3, n = (j >> 2) & 1, e = j & 3, w = wc * 16 + fq * 4 + e; col = (w >> 5) * 64 + (w & 31) + 32 * n; }
    float v[16];
#pragma unroll
    for (int i = 0; i < 16; ++i) v[i] = tile[(kq * 16 + i) * 129 + col];
    u32x4 w0, w1;
    w0.x = cvt_pk_bf16(v[0], v[1]); w0.y = cvt_pk_bf16(v[2], v[3]); w0.z = cvt_pk_bf16(v[4], v[5]); w0.w = cvt_pk_bf16(v[6], v[7]);
    w1.x = cvt_pk_bf16(v[8], v[9]); w1.y = cvt_pk_bf16(v[10], v[11]); w1.z = cvt_pk_bf16(v[12], v[13]); w1.w = cvt_pk_bf16(v[14], v[15]);
    if (wt) { const __amdgpu_buffer_rsrc_t rs = __builtin_amdgcn_make_buffer_rsrc((void*)d.dst, (short)0, 0x7ffff000, 0x00020000); const unsigned off = (unsigned)(j * d.ldd + d.k0 + kq * 16) * 2u;
        __builtin_amdgcn_raw_buffer_store_b128(w0, rs, off, 0, 16); __builtin_amdgcn_raw_buffer_store_b128(w1, rs, off + 16u, 0, 16); }
    else { bf16_t* dp = d.dst + (size_t)j * d.ldd + d.k0 + kq * 16; *(u32x4*)dp = w0; *(u32x4*)(dp + 8) = w1; }
}
__device__ __forceinline__ TrDesc tr_desc(const Params& P, unsigned char* ws, int id) {
    constexpr int T_IN = 128, T_OUT = 128, T_QKV = 192, T_O = 128, T_GU = 704, T_DN = 352;
    TrDesc d; d.perm = 0; d.pad = 0;
    if (id < T_IN) { const int rt = id >> 4, kt = id & 15; d.src = P.in[12]; d.ld = 1536; d.col0 = rt * 128; d.k0 = kt * 64; d.ldd = D; d.dst = (bf16_t*)(ws + WS_WIN) + (size_t)rt * 128 * D; }
    else if ((id -= T_IN) < T_OUT) { const int rt = id >> 4, kt = id & 15; d.src = P.in[16]; d.ld = 1024; d.col0 = rt * 128; d.k0 = kt * 64; d.ldd = D; d.dst = (bf16_t*)(ws + WS_WOUT) + (size_t)rt * 128 * D; }
    else if ((id -= T_OUT) < T_QKV) { const int rt = id >> 4, kt = id & 15; d.src = P.in[17]; d.ld = 1536; d.col0 = rt * 128; d.k0 = kt * 64; d.ldd = D; d.perm = rt < 10; d.dst = (bf16_t*)(ws + WS_WQKV) + (size_t)rt * 128 * D; }
    else if ((id -= T_QKV) < T_O) { const int rt = id >> 4, kt = id & 15; d.src = P.in[19]; d.ld = 1024; d.col0 = rt * 128; d.k0 = kt * 64; d.ldd = D; d.dst = (bf16_t*)(ws + WS_WO) + (size_t)rt * 128 * D; }
    else if ((id -= T_O) < 2 * T_GU) { const int l = id / T_GU, r = id % T_GU, rt = r >> 4, kt = r & 15, pn = rt >> 1, bj = rt & 1;
        d.src = (bj ? P.in[21] : P.in[20]) + (size_t)l * D * DFF; d.ld = DFF; d.col0 = pn * 128; d.k0 = kt * 64; d.ldd = D; d.dst = (bf16_t*)(ws + WS_WGU) + ((size_t)l * 5632 + (size_t)rt * 128) * D; }
    else { id -= 2 * T_GU; const int l = id / T_DN, r = id % T_DN, rt = r / 44, kt = r % 44;
        d.src = P.in[22] + (size_t)l * DFF * D; d.ld = D; d.col0 = rt * 128; d.k0 = kt * 64; d.ldd = DFF; d.dst = (bf16_t*)(ws + WS_WDN) + ((size_t)l * 1024 + (size_t)rt * 128) * DFF; }
    return d;
}

constexpr int TR_N0 = 128 + 128 + 704 + 352, TR_N1 = 0, TR_N2 = 192 + 128 + 704 + 352;
__device__ __forceinline__ int tr_map(int list, int j) {
    if (list == 0) return j < 256 ? j : (j < 256 + 704 ? 576 + (j - 256) : 1984 + (j - 960));
    if (list == 1) return 256 + j;
    return j < 320 ? 256 + j : (j < 320 + 704 ? 1280 + (j - 320) : 2336 + (j - 1024));
}
__device__ __forceinline__ int start_after(int c, int n_before, int G) { int it = c; while (it < n_before) it += G; return it - n_before; }
__device__ __forceinline__ void tr_run(const Params& P, unsigned char* ws, LAS float* tile, int list, int j0, int step, int tid) {
    const int n = list == 0 ? TR_N0 : (list == 1 ? TR_N1 : TR_N2);
    int j = j0; bool valid = j < n;
    TrDesc d; f32x4 v[4];
    if (valid) { d = tr_desc(P, ws, tr_map(list, j)); tr_load(d, v, tid); }
    while (valid) {
        tr_put(tile, v, tid);
        __syncthreads();
        const int nj = j + step; const bool nvalid = nj < n; TrDesc nd = d;
        if (nvalid) { nd = tr_desc(P, ws, tr_map(list, nj)); tr_load(nd, v, tid); }
        tr_store(tile, d, tid, list == 2);
        __syncthreads();
        j = nj; valid = nvalid; d = nd;
    }
}

__device__ __forceinline__ void p0_prologue(const Params& P, LAS unsigned char* lds, int tid) {
    unsigned char* ws = P.ws;
    LAS float* tile = (LAS float*)lds;
    const int G = gridDim.x;
    constexpr int N_FOLD = 64, N_MOD = 96, N_CS = 68, N_CACHE = 16, N_ZERO = 9;
    constexpr int I_MOD = N_FOLD, I_CS = I_MOD + N_MOD, I_CACHE = I_CS + N_CS, I_ZERO = I_CACHE + N_CACHE, I_TR = I_ZERO + N_ZERO;
    constexpr int T_IN = 128, T_OUT = 128, T_QKV = 192, T_O = 128, T_GU = 704, T_DN = 352;
    constexpr int N_TR = T_IN + T_OUT + T_QKV + T_O + 2 * T_GU + 2 * T_DN;
    for (int it = blockIdx.x; it < I_TR; it += G) {
        if (it < I_MOD) {
            const int g = it >> 4, kt = it & 15;
            LAS float* tab = tile + 64 * 129;
            const float* src = P.in[12];
#pragma unroll
            for (int i = 0; i < 4; ++i) { const int kk = (tid >> 5) + 16 * i, c4 = (tid & 31) * 4;
                const f32x4 v = *(const f32x4*)(src + (size_t)(kt * 64 + kk) * 1536 + 1024 + g * 128 + c4);
                tile[kk * 129 + c4] = v[0]; tile[kk * 129 + c4 + 1] = v[1]; tile[kk * 129 + c4 + 2] = v[2]; tile[kk * 129 + c4 + 3] = v[3]; }
            if (tid < 128) tab[tid] = cosf((float)tid * (6.283185307179586f / 128.0f)) * 0.08838834764831845f;
            __syncthreads();
            const int c = tid & 127, kg = tid >> 7;
            float aP[16], aQ[16];
#pragma unroll
            for (int i = 0; i < 16; ++i) { aP[i] = 0.f; aQ[i] = 0.f; }
            for (int cp = 0; cp < 128; ++cp) { const int mi = (c * cp) & 127; const float tc = tab[mi], ts = tab[(mi + 96) & 127];
#pragma unroll
                for (int i = 0; i < 16; ++i) { const float x = tile[(kg * 16 + i) * 129 + cp]; aP[i] += x * tc; aQ[i] += x * ts; } }
            bf16_t* W = (bf16_t*)(ws + WS_WIN);
            u32x4 w0, w1;
            w0.x = cvt_pk_bf16(aP[0], aP[1]); w0.y = cvt_pk_bf16(aP[2], aP[3]); w0.z = cvt_pk_bf16(aP[4], aP[5]); w0.w = cvt_pk_bf16(aP[6], aP[7]);
            w1.x = cvt_pk_bf16(aP[8], aP[9]); w1.y = cvt_pk_bf16(aP[10], aP[11]); w1.z = cvt_pk_bf16(aP[12], aP[13]); w1.w = cvt_pk_bf16(aP[14], aP[15]);
            bf16_t* dp = W + (size_t)(1024 + g * 128 + c) * D + kt * 64 + kg * 16; *(u32x4*)dp = w0; *(u32x4*)(dp + 8) = w1;
            w0.x = cvt_pk_bf16(aQ[0], aQ[1]); w0.y = cvt_pk_bf16(aQ[2], aQ[3]); w0.z = cvt_pk_bf16(aQ[4], aQ[5]); w0.w = cvt_pk_bf16(aQ[6], aQ[7]);
            w1.x = cvt_pk_bf16(aQ[8], aQ[9]); w1.y = cvt_pk_bf16(aQ[10], aQ[11]); w1.z = cvt_pk_bf16(aQ[12], aQ[13]); w1.w = cvt_pk_bf16(aQ[14], aQ[15]);
            dp = W + (size_t)(1536 + g * 128 + c) * D + kt * 64 + kg * 16; *(u32x4*)dp = w0; *(u32x4*)(dp + 8) = w1;
            __syncthreads();
        } else if (it < I_CS) {
            const int id = it - I_MOD, l = id / 48, cgp = id % 48;
            LAS float* sc = tile;
            LAS float* red = tile + 9 * 1024;
            for (int idx = tid; idx < 9 * 1024; idx += 512) { const int r = idx >> 10, k = idx & 1023; const float v = r == 0 ? P.in[5][k] : P.in[4][(r - 1) * 1024 + k]; sc[idx] = v / (1.0f + expf(-v)); }
            __syncthreads();
            const int c4 = (tid & 31) * 4, kg = tid >> 5;
            const float* wp = P.in[6] + (size_t)l * 1024 * 6144 + (size_t)(kg * 64) * 6144 + cgp * 128 + c4;
            f32x4 a[9];
#pragma unroll
            for (int r = 0; r < 9; ++r) a[r] = (f32x4){0.f, 0.f, 0.f, 0.f};
            for (int k = 0; k < 64; k += 16) { f32x4 w[16];
#pragma unroll
                for (int j = 0; j < 16; ++j) w[j] = *(const f32x4*)(wp + (size_t)(k + j) * 6144);
#pragma unroll
                for (int j = 0; j < 16; ++j)
#pragma unroll
                    for (int r = 0; r < 9; ++r) { const float sv = sc[r * 1024 + kg * 64 + k + j]; a[r] += w[j] * sv; } }
#pragma unroll
            for (int r = 0; r < 9; ++r) *(LAS f32x4*)(red + (kg * 9 + r) * 128 + c4) = a[r];
            __syncthreads();
            float* MOD = (float*)(ws + WS_MOD);
            for (int idx = tid; idx < 9 * 128; idx += 512) { const int r = idx >> 7, cc = idx & 127; float sacc = 0.f;
#pragma unroll
                for (int g2 = 0; g2 < 16; ++g2) sacc += red[(g2 * 9 + r) * 128 + cc];
                MOD[((size_t)l * 9 + r) * 6144 + cgp * 128 + cc] = sacc + P.in[7][l * 6144 + cgp * 128 + cc]; }
            __syncthreads();
        } else if (it < I_CACHE) {
            const int id = it - I_CS;
            const bool big = id < 64; const int T = big ? 1024 : 256; const float sc = big ? (1.0f / 32.0f) : (1.0f / 16.0f);
            bf16_t* tabp = (bf16_t*)(ws + (big ? WS_CS1024 : WS_CS256));
            const int e0 = (big ? id : id - 64) * 32768;
            for (int ch = tid; ch < 4096; ch += 512) { const int e = e0 + ch * 8; const int t = e / (2 * T), kk0 = e % (2 * T);
                float v[8];
#pragma unroll
                for (int j = 0; j < 8; ++j) { const int kk = kk0 + j, jj = kk & (T - 1), mi = (t * jj) & (T - 1); const float rev = (float)mi / (float)T;
                    const float s = __builtin_amdgcn_sinf(rev), c = __builtin_amdgcn_cosf(rev); v[j] = (kk < T ? c : -s) * sc; }
                u32x4 w; w.x = cvt_pk_bf16(v[0], v[1]); w.y = cvt_pk_bf16(v[2], v[3]); w.z = cvt_pk_bf16(v[4], v[5]); w.w = cvt_pk_bf16(v[6], v[7]);
                *(u32x4*)(tabp + e) = w; }
        } else if (it < I_ZERO) {
            const int id = it - I_CACHE;
            if (id < 8) { bf16_t* CK = (bf16_t*)(ws + WS_CK);
                for (int ch = tid; ch < 8192; ch += 512) { const int e = id * 65536 + ch * 8; const int d0 = e & 127, pos = (e >> 7) & 255, kv = (e >> 15) & 1, b = e >> 16;
                    const float* sp = P.in[2] + ((size_t)(b * 256 + pos) * 2 + kv) * 128 + d0; const f32x4 a = *(const f32x4*)sp, c = *(const f32x4*)(sp + 4);
                    *(u32x4*)(CK + e) = pack8(a, c); } }
            else { bf16_t* CVT = (bf16_t*)(ws + WS_CVT);
                for (int ch = tid; ch < 8192; ch += 512) { const int e = (id - 8) * 65536 + ch * 8; const int pos0 = e & 255, d = (e >> 8) & 127, kv = (e >> 15) & 1, b = e >> 16;
                    float v[8];
#pragma unroll
                    for (int j = 0; j < 8; ++j) v[j] = P.in[3][((size_t)(b * 256 + pos0 + j) * 2 + kv) * 128 + d];
                    u32x4 w; w.x = cvt_pk_bf16(v[0], v[1]); w.y = cvt_pk_bf16(v[2], v[3]); w.z = cvt_pk_bf16(v[4], v[5]); w.w = cvt_pk_bf16(v[6], v[7]);
                    *(u32x4*)(CVT + e) = w; } }
        } else if (it < I_TR) {
            const int id = it - I_ZERO;
            if (id == 0) { f32x4* z = (f32x4*)(ws + WS_STATS);
                for (int i = tid; i < (6 * 16384) / 4; i += 512) z[i] = (f32x4){0.f, 0.f, 0.f, 0.f}; }
            else { float* rope = (float*)(ws + WS_ROPE);
                for (int e = (id - 1) * 8192 + tid; e < id * 8192; e += 512) { const int t = e >> 6, jx = e & 63, ax = jx >> 5, i = jx & 31;
                    const float inv = powf(10000.0f, -(float)(2 * i) / 64.0f), pos = (float)(ax ? (t & 63) : (t >> 6)), ang = pos * inv;
                    float sv, cv; sincosf(ang, &sv, &cv); rope[e] = cv; rope[65536 + e] = sv; } }
        }
    }
    tr_run(P, ws, tile, 0, start_after(blockIdx.x, I_TR, G), G, tid);
}

template <int MODE>
__device__ __forceinline__ void ew_phase(const float* xa, const float* xb, const bf16_t* Xin, const bf16_t* Gm, const float* rowss, const float* gate, const float* gpost,
                                         bf16_t* Xout, float* Y, bf16_t* H, const float* gpre, const float* shift, const float* scale, int tid) {
    constexpr int R = 4;
    const int lane = tid & 63;
    const int first = (int)(blockIdx.x & 63) * 256 + (int)(blockIdx.x >> 6) * 64 + (tid >> 6) * 8;
    for (int r0 = first; r0 < first + 8; r0 += R) {
        const int mrow = r0 < NP ? 0 : 1 + ((r0 - NP) >> 10);
        f32x4 x[R][4]; u32x2 gq[R][4]; float alpha[R];
#pragma unroll
        for (int i = 0; i < R; ++i) { const int r = r0 + i;
            if (MODE <= 1) { const float* xr = r < NP ? xa + (size_t)r * D : xb + (size_t)(r - NP) * D;
#pragma unroll
                for (int j = 0; j < 4; ++j) x[i][j] = *(const f32x4*)(xr + j * 256 + lane * 4); }
            else {
#pragma unroll
                for (int j = 0; j < 4; ++j) { const u32x2 w = *(const u32x2*)(Xin + (size_t)r * D + j * 256 + lane * 4); x[i][j] = (f32x4){bf_lo(w.x), bf_hi(w.x), bf_lo(w.y), bf_hi(w.y)}; } }
            if (MODE != 0) { alpha[i] = rowss[r];
#pragma unroll
                for (int j = 0; j < 4; ++j) gq[i][j] = *(const u32x2*)(Gm + (size_t)r * D + j * 256 + lane * 4); } }
        if (MODE != 0) {
#pragma unroll
            for (int j = 0; j < 4; ++j) { const int c = j * 256 + lane * 4;
                const f32x4 gt = *(const f32x4*)(gate + (size_t)mrow * 6144 + c), gp = *(const f32x4*)(gpost + c);
                const f32x4 gg = gt * gp;
#pragma unroll
                for (int i = 0; i < R; ++i) { const int r = r0 + i; const float al = rsqrtf(alpha[i] * (1.0f / 1024.0f) + EPS);
                    x[i][j][0] += gg[0] * (bf_lo(gq[i][j].x) * al); x[i][j][1] += gg[1] * (bf_hi(gq[i][j].x) * al);
                    x[i][j][2] += gg[2] * (bf_lo(gq[i][j].y) * al); x[i][j][3] += gg[3] * (bf_hi(gq[i][j].y) * al);
                    if (MODE == 3) *(f32x4*)(Y + (size_t)r * D + c) = x[i][j];
                    else { u32x2 w; w.x = cvt_pk_bf16(x[i][j][0], x[i][j][1]); w.y = cvt_pk_bf16(x[i][j][2], x[i][j][3]); *(u32x2*)(Xout + (size_t)r * D + c) = w;
                           x[i][j] = (f32x4){bf_lo(w.x), bf_hi(w.x), bf_lo(w.y), bf_hi(w.y)}; } } }
        }
        if (MODE != 3) {
            float rs[R];
#pragma unroll
            for (int i = 0; i < R; ++i) { float ss = 0.f;
#pragma unroll
                for (int j = 0; j < 4; ++j) ss += (x[i][j][0] * x[i][j][0] + x[i][j][1] * x[i][j][1]) + (x[i][j][2] * x[i][j][2] + x[i][j][3] * x[i][j][3]);
                rs[i] = ss; }
#pragma unroll
            for (int sft = 1; sft < 64; sft <<= 1)
#pragma unroll
                for (int i = 0; i < R; ++i) rs[i] += __shfl_xor(rs[i], sft);
#pragma unroll
            for (int i = 0; i < R; ++i) rs[i] = rsqrtf(rs[i] * (1.0f / 1024.0f) + EPS);
#pragma unroll
            for (int j = 0; j < 4; ++j) { const int c = j * 256 + lane * 4;
                const f32x4 g = *(const f32x4*)(gpre + c), sh = *(const f32x4*)(shift + (size_t)mrow * 6144 + c), sl = *(const f32x4*)(scale + (size_t)mrow * 6144 + c);
                const f32x4 gs = g * (sl + 1.0f);
#pragma unroll
                for (int i = 0; i < R; ++i) { f32x4 h;
#pragma unroll
                    for (int e = 0; e < 4; ++e) h[e] = (x[i][j][e] * rs[i]) * gs[e] + sh[e];
                    u32x2 w; w.x = cvt_pk_bf16(h[0], h[1]); w.y = cvt_pk_bf16(h[2], h[3]);
                    *(u32x2*)(H + (size_t)(r0 + i) * D + c) = w; } }
        }
    }
}

__device__ __forceinline__ void gmlp_item(LAS unsigned char* lds, int id, const float* sgu_w, const float* sgu_b, const float* sgu_g,
                                          const bf16_t* U, const bf16_t* VT, bf16_t* AB, int tid, bool need_stats) {
    const int chunk = id >> 2, h = id & 3, tok0 = chunk * 128;
    LAS bf16_t* Wl = (LAS bf16_t*)lds;
    LAS bf16_t* Vl = (LAS bf16_t*)(lds + 128 * 136 * 2);
    LAS float* rl = (LAS float*)(lds + 2 * 128 * 136 * 2);
    LAS float* rmu = rl + 128; LAS float* betal = rmu + 128;
    if (need_stats) {
        LAS float* red = betal + 128;
        const int tc = tid & 15, cg = tid >> 4; float sm[8], sq[8];
#pragma unroll
        for (int e = 0; e < 8; ++e) { sm[e] = 0.f; sq[e] = 0.f; }
#pragma unroll 4
        for (int j = 0; j < 16; ++j) { const u32x4 v = *(const u32x4*)(VT + (size_t)(cg * 16 + j) * NTOK + tok0 + tc * 8);
            const unsigned wv[4] = {v.x, v.y, v.z, v.w};
#pragma unroll
            for (int e = 0; e < 4; ++e) { const float lo = bf_lo(wv[e]), hi = bf_hi(wv[e]); sm[2 * e] += lo; sq[2 * e] += lo * lo; sm[2 * e + 1] += hi; sq[2 * e + 1] += hi * hi; } }
#pragma unroll
        for (int e = 0; e < 8; ++e) { sm[e] += __shfl_xor(sm[e], 16); sm[e] += __shfl_xor(sm[e], 32); sq[e] += __shfl_xor(sq[e], 16); sq[e] += __shfl_xor(sq[e], 32); }
        if ((tid & 63) < 16) {
#pragma unroll
            for (int e = 0; e < 8; ++e) { red[((tid >> 6) * 2 + 0) * 128 + tc * 8 + e] = sm[e]; red[((tid >> 6) * 2 + 1) * 128 + tc * 8 + e] = sq[e]; } }
        __syncthreads();
        if (tid < 128) { float s = 0.f, q = 0.f;
#pragma unroll
            for (int w8 = 0; w8 < 8; ++w8) { s += red[(w8 * 2 + 0) * 128 + tid]; q += red[(w8 * 2 + 1) * 128 + tid]; }
            const float mu = s * (1.0f / 512.0f), var = q * (1.0f / 512.0f) - mu * mu, r = rsqrtf(var + EPS); rl[tid] = r; rmu[tid] = r * mu; }
    }
#pragma unroll
    for (int i = 0; i < 4; ++i) { const int cidx = tid + 512 * i, row = cidx >> 4, cc = cidx & 15;
        const u32x4 v = *(const u32x4*)(VT + (size_t)(h * 128 + row) * NTOK + tok0 + cc * 8);
        *(LAS u32x4*)(Vl + row * 136 + cc * 8) = v; }
    __syncthreads();
    { const int p = tid >> 2, q0 = (tid & 3) * 32; const float* wp = sgu_w + ((size_t)h * 128 + p) * 128 + q0; float beta = 0.f;
#pragma unroll
        for (int j = 0; j < 32; j += 4) { const f32x4 w = *(const f32x4*)(wp + j); float ws4[4];
#pragma unroll
            for (int e = 0; e < 4; ++e) { ws4[e] = w[e] * rl[q0 + j + e]; beta += w[e] * rmu[q0 + j + e]; }
            u32x2 pk; pk.x = cvt_pk_bf16(ws4[0], ws4[1]); pk.y = cvt_pk_bf16(ws4[2], ws4[3]);
            *(LAS u32x2*)(Wl + p * 136 + q0 + j) = pk; }
        beta += __shfl_xor(beta, 1); beta += __shfl_xor(beta, 2);
        if ((tid & 3) == 0) betal[p] = beta; }
    __syncthreads();
    const int w = tid >> 6, lane = tid & 63, l15 = lane & 15, s = lane >> 4;
    f32x4 acc[8];
#pragma unroll
    for (int cb = 0; cb < 8; ++cb) acc[cb] = (f32x4){0.f, 0.f, 0.f, 0.f};
#pragma unroll
    for (int ks = 0; ks < 4; ++ks) { const bf16x8 bw = *(const LAS bf16x8*)(Wl + (16 * w + l15) * 136 + ks * 32 + s * 8);
#pragma unroll
        for (int cb = 0; cb < 8; ++cb) { const bf16x8 av = *(const LAS bf16x8*)(Vl + (cb * 16 + l15) * 136 + ks * 32 + s * 8);
            acc[cb] = __builtin_amdgcn_mfma_f32_16x16x32_bf16(av, bw, acc[cb], 0, 0, 0); } }
    const int p = 16 * w + l15; const float beta = betal[p], bp = sgu_b[h * 128 + p];
    const size_t trow = (size_t)(tok0 + p);
#pragma unroll
    for (int cb = 0; cb < 8; ++cb) { const int c = h * 128 + cb * 16 + 4 * s;
        const f32x4 g = *(const f32x4*)(sgu_g + c); const u32x2 uu = *(const u32x2*)(U + trow * 512 + c);
        const float a0 = bf_lo(uu.x) * (g[0] * (acc[cb][0] - beta) + bp), a1 = bf_hi(uu.x) * (g[1] * (acc[cb][1] - beta) + bp);
        const float a2 = bf_lo(uu.y) * (g[2] * (acc[cb][2] - beta) + bp), a3 = bf_hi(uu.y) * (g[3] * (acc[cb][3] - beta) + bp);
        u32x2 o; o.x = cvt_pk_bf16(a0, a1); o.y = cvt_pk_bf16(a2, a3);
        *(u32x2*)(AB + trow * D + c) = o; }
    __syncthreads();
}

__device__ __forceinline__ void attn_item(LAS unsigned char* lds, int it, const bf16_t* Q, const bf16_t* Kb, const bf16_t* VT, const bf16_t* CK, const bf16_t* CVT,
                                          const float* sink, bf16_t* AO, int tid) {
    LAS bf16_t* Kl = (LAS bf16_t*)lds;
    LAS bf16_t* Vl = (LAS bf16_t*)(lds + 64 * 136 * 2);
    const bool latent = it < 256;
    int b, head, row0, nband = 0, kb0 = 0, ntiles, start = 0;
    if (latent) { const int qb = it & 3; head = (it >> 2) & 7; b = it >> 5; start = qb * 256; row0 = NP + b * 1024 + start;
        kb0 = start - 128 < 0 ? 0 : start - 128; const int kb1 = start + 384 > 1024 ? 1024 : start + 384; nband = (kb1 - kb0) >> 6; ntiles = nband + 4; }
    else { const int id = it - 256; b = id & 31; head = 2 * ((id >> 5) & 3) + (id >> 7); row0 = b * 256; ntiles = 4; }
    const int kv = head >> 2;
    const int w = tid >> 6, lane = tid & 63, l15 = lane & 15, s = lane >> 4;
    const int qmin = start + 32 * w, qmax = qmin + 31;
    bf16x8 qf[2][4];
#pragma unroll
    for (int qi = 0; qi < 2; ++qi)
#pragma unroll
        for (int ks = 0; ks < 4; ++ks) qf[qi][ks] = *(const bf16x8*)(Q + (size_t)(row0 + 32 * w + 16 * qi + l15) * D + head * 128 + ks * 32 + s * 8);
    const float sk2 = sink[head] * LOG2E;
    float mrun[2] = {sk2, sk2}, lrun[2]; lrun[0] = lrun[1] = (s == 0) ? 1.0f : 0.0f;
    f32x4 o[2][8];
#pragma unroll
    for (int qi = 0; qi < 2; ++qi)
#pragma unroll
        for (int db = 0; db < 8; ++db) o[qi][db] = (f32x4){0.f, 0.f, 0.f, 0.f};
    u32x4 kregA[2], vregA[2], kregB[2], vregB[2];
    auto gload = [&](int t, u32x4 (&kreg)[2], u32x4 (&vreg)[2]) {
        const bf16_t* ks_; int kstr; const bf16_t* vs_; int vstr;
        if (latent && t >= nband) { const int c0 = (t - nband) * 64; ks_ = CK + ((size_t)(b * 2 + kv) * 256 + c0) * 128; kstr = 128; vs_ = CVT + (size_t)(b * 2 + kv) * 128 * 256 + c0; vstr = 256; }
        else { const int tokb = latent ? NP + b * 1024 + kb0 + t * 64 : b * 256 + t * 64; ks_ = Kb + (size_t)tokb * 256 + kv * 128; kstr = 256; vs_ = VT + (size_t)(kv * 128) * NTOK + tokb; vstr = NTOK; }
#pragma unroll
        for (int i = 0; i < 2; ++i) { const int cidx = tid + 512 * i;
            kreg[i] = *(const u32x4*)(ks_ + (size_t)(cidx >> 4) * kstr + (cidx & 15) * 8);
            vreg[i] = *(const u32x4*)(vs_ + (size_t)(cidx >> 3) * vstr + (cidx & 7) * 8); }
    };
    auto stage = [&](const u32x4 (&kreg)[2], const u32x4 (&vreg)[2]) {
        __syncthreads();
#pragma unroll
        for (int i = 0; i < 2; ++i) { const int cidx = tid + 512 * i;
            *(LAS u32x4*)(Kl + (cidx >> 4) * 136 + (cidx & 15) * 8) = kreg[i];
            *(LAS u32x4*)(Vl + (cidx >> 3) * 72 + (cidx & 7) * 8) = vreg[i]; }
        __syncthreads();
    };
    auto compute = [&](int t) {
        const bool band = latent && t < nband;
        const int kp0 = kb0 + t * 64;
        if (band && (kp0 > qmax + 128 || kp0 + 63 < qmin - 128)) return;
        f32x4 sc[2][4];
        {
            bf16x8 kf[2][4];
#pragma unroll
            for (int ks = 0; ks < 4; ++ks) kf[0][ks] = *(const LAS bf16x8*)(Kl + l15 * 136 + ks * 32 + s * 8);
#pragma unroll
            for (int nb = 0; nb < 4; ++nb) {
                if (nb < 3) {
#pragma unroll
                    for (int ks = 0; ks < 4; ++ks) kf[(nb + 1) & 1][ks] = *(const LAS bf16x8*)(Kl + ((nb + 1) * 16 + l15) * 136 + ks * 32 + s * 8); }
                __builtin_amdgcn_sched_barrier(0);
                sc[0][nb] = (f32x4){0.f, 0.f, 0.f, 0.f}; sc[1][nb] = (f32x4){0.f, 0.f, 0.f, 0.f};
#pragma unroll
                for (int ks = 0; ks < 4; ++ks) {
                    sc[0][nb] = __builtin_amdgcn_mfma_f32_16x16x32_bf16(kf[nb & 1][ks], qf[0][ks], sc[0][nb], 0, 0, 0);
                    sc[1][nb] = __builtin_amdgcn_mfma_f32_16x16x32_bf16(kf[nb & 1][ks], qf[1][ks], sc[1][nb], 0, 0, 0); }
                __builtin_amdgcn_sched_barrier(0);
            }
        }
        bf16x8 pf[2][2];
#pragma unroll
        for (int qi = 0; qi < 2; ++qi) {
            if (band) { const int qpos = qmin + 16 * qi + l15, kpb = kp0 + 4 * s;
#pragma unroll
                for (int nb = 0; nb < 4; ++nb)
#pragma unroll
                    for (int i = 0; i < 4; ++i) { const int dlt = qpos - (kpb + nb * 16 + i); if (dlt > 128 || dlt < -128) sc[qi][nb][i] = -1e30f; } }
            float tmax = -1e30f;
#pragma unroll
            for (int nb = 0; nb < 4; ++nb) tmax = fmaxf(tmax, fmaxf(fmaxf(sc[qi][nb][0], sc[qi][nb][1]), fmaxf(sc[qi][nb][2], sc[qi][nb][3])));
            tmax = fmaxf(tmax, __shfl_xor(tmax, 16)); tmax = fmaxf(tmax, __shfl_xor(tmax, 32));
            const float mnew = fmaxf(mrun[qi], tmax), corr = fast_exp2(mrun[qi] - mnew); mrun[qi] = mnew;
            float psum = 0.f;
#pragma unroll
            for (int nb = 0; nb < 4; ++nb)
#pragma unroll
                for (int i = 0; i < 4; ++i) { sc[qi][nb][i] = fast_exp2(sc[qi][nb][i] - mnew); psum += sc[qi][nb][i]; }
            lrun[qi] = lrun[qi] * corr + psum;
#pragma unroll
            for (int db = 0; db < 8; ++db) o[qi][db] *= corr;
#pragma unroll
            for (int kk = 0; kk < 2; ++kk) { u32x4 pw; pw.x = cvt_pk_bf16(sc[qi][2 * kk][0], sc[qi][2 * kk][1]); pw.y = cvt_pk_bf16(sc[qi][2 * kk][2], sc[qi][2 * kk][3]);
                pw.z = cvt_pk_bf16(sc[qi][2 * kk + 1][0], sc[qi][2 * kk + 1][1]); pw.w = cvt_pk_bf16(sc[qi][2 * kk + 1][2], sc[qi][2 * kk + 1][3]); pf[qi][kk] = __builtin_bit_cast(bf16x8, pw); }
        }
        {
            u32x2 vq[2][2][2][2];
            auto vload = [&](int g, int buf) {
#pragma unroll
                for (int dd = 0; dd < 2; ++dd)
#pragma unroll
                    for (int kk = 0; kk < 2; ++kk) { const LAS bf16_t* vp = Vl + ((2 * g + dd) * 16 + l15) * 72 + kk * 32 + 4 * s;
                        vq[buf][dd][kk][0] = *(const LAS u32x2*)vp; vq[buf][dd][kk][1] = *(const LAS u32x2*)(vp + 16); } };
            vload(0, 0);
#pragma unroll
            for (int g = 0; g < 4; ++g) {
                if (g < 3) vload(g + 1, (g + 1) & 1);
                __builtin_amdgcn_sched_barrier(0);
#pragma unroll
                for (int dd = 0; dd < 2; ++dd)
#pragma unroll
                    for (int kk = 0; kk < 2; ++kk) { u32x4 vw; vw.x = vq[g & 1][dd][kk][0].x; vw.y = vq[g & 1][dd][kk][0].y; vw.z = vq[g & 1][dd][kk][1].x; vw.w = vq[g & 1][dd][kk][1].y;
                        const bf16x8 vf = __builtin_bit_cast(bf16x8, vw);
                        o[0][2 * g + dd] = __builtin_amdgcn_mfma_f32_16x16x32_bf16(vf, pf[0][kk], o[0][2 * g + dd], 0, 0, 0);
                        o[1][2 * g + dd] = __builtin_amdgcn_mfma_f32_16x16x32_bf16(vf, pf[1][kk], o[1][2 * g + dd], 0, 0, 0); }
                __builtin_amdgcn_sched_barrier(0);
            }
        }
    };
    gload(0, kregA, vregA); gload(1, kregB, vregB);
    for (int t = 0; t < ntiles; t += 2) {
        stage(kregA, vregA); if (t + 2 < ntiles) gload(t + 2, kregA, vregA); compute(t);
        stage(kregB, vregB); if (t + 3 < ntiles) gload(t + 3, kregB, vregB); compute(t + 1);
    }
#pragma unroll
    for (int qi = 0; qi < 2; ++qi) {
        float l = lrun[qi]; l += __shfl_xor(l, 16); l += __shfl_xor(l, 32);
        const float inv = 1.0f / l;
        bf16_t* op = AO + (size_t)(row0 + 32 * w + 16 * qi + l15) * D + head * 128 + 4 * s;
#pragma unroll
        for (int db = 0; db < 8; ++db) { u32x2 ow; ow.x = cvt_pk_bf16(o[qi][db][0] * inv, o[qi][db][1] * inv); ow.y = cvt_pk_bf16(o[qi][db][2] * inv, o[qi][db][3] * inv); *(u32x2*)(op + db * 16) = ow; }
    }
    __syncthreads();
}

__global__ void __launch_bounds__(512, 2) fwd_kernel(Params P) {
    extern __shared__ __attribute__((aligned(16))) unsigned char lds_raw[];
    LAS unsigned char* lds = (LAS unsigned char*)lds_raw;
    const int tid = threadIdx.x;
    const int G = gridDim.x, c = blockIdx.x;
    unsigned char* ws = P.ws;
    const int lo = P.ph_lo, hi = P.ph_hi;
    float* MOD = (float*)(ws + WS_MOD);
    float* rowss = (float*)(ws + WS_STATS);
    float* vstat = rowss + 4 * 16384;
    bf16_t* H = (bf16_t*)(ws + WS_H);
    bf16_t* R2 = (bf16_t*)(ws + WS_R2);
    bf16_t* R3 = (bf16_t*)(ws + WS_R3);
    bf16_t* HF = (bf16_t*)(ws + WS_R1);
    bf16_t* X = (bf16_t*)(ws + WS_X);
#ifndef PHASE_MASK
#define PHASE_MASK 0xffff
#endif
    volatile LAS unsigned* xst = (volatile LAS unsigned*)(lds + LDS_BYTES - 64);
    if (tid < 2) xst[tid] = 0u;
    __syncthreads();
#if !MK_PER_PHASE
    XcdBarrier xbar = xcd_barrier_post((unsigned*)(ws + WS_BAR), xst);
#else
    XcdBarrier xbar; xbar.bar = nullptr; xbar.x = 0; xbar.st = xst;
#endif
#ifndef REPEAT_MASK
#define REPEAT_MASK 0
#endif
#define REP(k) (((REPEAT_MASK) >> (k)) & 1)
#define IN(k) ((((PHASE_MASK) >> (k)) & 1) && lo <= (k) && (k) < hi)
#if MK_PER_PHASE
#define SEAM(k) do {} while (0)
#define GSEAM(k, kn, idx) do {} while (0)
#else
#define SEAM(k) do { if (IN(k) && IN((k) + 1)) xcd_barrier(xbar); } while (0)
#define GSEAM(k, kn, idx) do { if (IN(k) && IN(kn)) grp_sync((unsigned*)(ws + WS_BAR) + XCD_BAR_WORDS + 1024 + ((idx) * 64 + (c & 63)) * 4, (unsigned*)(ws + WS_BAR)); } while (0)
#endif
    if (hi > 1000) cg::this_grid().sync();
    if (IN(0)) for (int rep = 0; rep <= REP(0); ++rep) { if (rep) xcd_barrier(xbar); p0_prologue(P, lds, tid); } SEAM(0);
    if (IN(1)) { ew_phase<0>(P.in[0], P.in[1], nullptr, nullptr, nullptr, nullptr, nullptr, nullptr, nullptr, H, P.in[8], MOD + 0 * 1024, MOD + 1 * 1024, tid); } GSEAM(1, 2, 4);
    if (IN(2)) for (int rep = 0; rep <= REP(2); ++rep) { if (rep) xcd_barrier(xbar); SchedL0 S{(const char*)H, (const char*)(ws + WS_WIN), G, c};
        EpiL0 E{(bf16_t*)(ws + WS_R1 + R1_U), (bf16_t*)(ws + WS_R1 + R1_VT0), (bf16_t*)(ws + WS_R1 + R1_PQT)};
        pg8::gemm_phase(lds, D, S, E); } SEAM(2);
    if (IN(3)) for (int rep = 0; rep <= REP(3); ++rep) { if (rep) xcd_barrier(xbar);
        { SchedFH S{(const char*)(ws + WS_CS1024), (const char*)(ws + WS_R1 + R1_PQT), G, c};
          EpiSplitK E{R2, D, 512, (float*)(ws + WS_R3), (unsigned*)(ws + WS_BAR) + XCD_BAR_WORDS + 512, (unsigned*)(ws + WS_BAR)}; pg8::gemm_phase(lds, 1024, S, E, 2048); }
        { SchedFL S{(const char*)(ws + WS_CS256), (const char*)(ws + WS_R1 + R1_PQT), G, c}; EpiPlain E{R2, D, 512}; pg8::gemm_phase(lds, 512, S, E); }
        const int nfree = G - 128; const int vb = (G - 1) - c;
        if (vb < nfree) { const int lo = vb < 64 ? 5 * vb : 320 + 3 * (vb - 64), hi = lo + (vb < 64 ? 5 : 3);
            for (int id = lo; id < hi; ++id)
                gmlp_item(lds, id, P.in[13], P.in[14], P.in[15], (const bf16_t*)(ws + WS_R1 + R1_U), (const bf16_t*)(ws + WS_R1 + R1_VT0), R2, tid, id == lo || (id & 3) == 0); }
        if (rep == 0 && vb < nfree) tr_run(P, ws, (LAS float*)lds, 1, vb, nfree, tid);
    } SEAM(3);
    if (IN(4)) { SchedNat S{(const char*)R2, (const char*)(ws + WS_WOUT), D, 4, G, c};
        EpiResNorm<true> E{P.in[0], P.in[1], nullptr, X, H, MOD + 2 * 1024, P.in[9], P.in[10], MOD + 3 * 1024, MOD + 4 * 1024,
            (float*)(ws + WS_SLOTS) + 1 * 65536, (float*)(ws + WS_SLOTS) + 2 * 65536, (unsigned*)(ws + WS_BAR) + XCD_BAR_WORDS + 64 * 1, (unsigned*)(ws + WS_BAR) + XCD_BAR_WORDS + 64 * 2, (unsigned*)(ws + WS_BAR)};
        pg8::gemm_phase(lds, D, S, E); } GSEAM(4, 6, 0);
    if (IN(6)) for (int rep = 0; rep <= REP(6); ++rep) { if (rep) xcd_barrier(xbar); SchedNat S{(const char*)H, (const char*)(ws + WS_WGU), D, 22, G, c}; EpiSwiGLU E{HF}; pg8::gemm_phase(lds, D, S, E);
        if (rep == 0 && c >= 128) { tr_run(P, ws, (LAS float*)lds, 2, c - 128, G - 128, tid);
            asm volatile("s_waitcnt vmcnt(0)" ::: "memory"); __syncthreads();
            if (tid == 0) (void)xb_add((unsigned*)(ws + WS_BAR) + XB_TRCNT, 1u); }
    } GSEAM(6, 7, 1);
    if (IN(7)) { SchedNat S{(const char*)HF, (const char*)(ws + WS_WDN), DFF, 4, G, c};
        EpiResNorm<false> E{nullptr, nullptr, X, X, H, MOD + 5 * 1024, P.in[11], P.in[8] + 1024, MOD + 9 * 6144 + 0 * 1024, MOD + 9 * 6144 + 1 * 1024,
            (float*)(ws + WS_SLOTS) + 3 * 65536, (float*)(ws + WS_SLOTS) + 4 * 65536, (unsigned*)(ws + WS_BAR) + XCD_BAR_WORDS + 64 * 3, (unsigned*)(ws + WS_BAR) + XCD_BAR_WORDS + 64 * 4, (unsigned*)(ws + WS_BAR)};
        pg8::gemm_phase(lds, DFF, S, E); }
    if (IN(7) && IN(9)) grp_sync((unsigned*)(ws + WS_BAR) + XCD_BAR_WORDS + 1024 + (6 * 64 + (c & 31)) * 4, (unsigned*)(ws + WS_BAR), 8u);
    if (IN(9)) {
        if (IN(6)) {
            if (tid == 0) { unsigned* bw = (unsigned*)(ws + WS_BAR); XB_SPIN(xb_ld(bw + XB_TRCNT) < (unsigned)(G - 128), bw); __builtin_amdgcn_fence(__ATOMIC_ACQUIRE, "agent"); asm volatile("s_waitcnt vmcnt(0)" ::: "memory"); }
            __syncthreads(); }
        EpiQKV E{(bf16_t*)(ws + WS_Q), (bf16_t*)(ws + WS_K1), (bf16_t*)(ws + WS_VT1), P.out + (size_t)2 * NP * D, P.out + (size_t)2 * NP * D + (size_t)NP * 256, (const float*)(ws + WS_ROPE)};
        { SchedQKV S{(const char*)H, (const char*)(ws + WS_WQKV), G, c, 0}; pg8::gemm_phase(lds, D, S, E); }
        grp_sync((unsigned*)(ws + WS_BAR) + XCD_BAR_WORDS + 1024 + (7 * 64 + (c & 31)) * 4, (unsigned*)(ws + WS_BAR), 8u);
        { SchedQKV S{(const char*)H, (const char*)(ws + WS_WQKV), G, c, 1}; pg8::gemm_phase(lds, D, S, E); }
        const int cb = G > 128 ? c - 128 : c, cs = G > 128 ? G - 128 : G;
        if (cb >= 0) for (int it = 256 + cb; it < 512; it += cs)
            attn_item(lds, it, (const bf16_t*)(ws + WS_Q), (const bf16_t*)(ws + WS_K1), (const bf16_t*)(ws + WS_VT1), (const bf16_t*)(ws + WS_CK), (const bf16_t*)(ws + WS_CVT), P.in[18], R2, tid);
    }
    if (IN(9) && IN(10)) {
        unsigned* bw = (unsigned*)(ws + WS_BAR); const int bb = (c & 31) >> 2, kq = c >> 5;
        asm volatile("s_waitcnt vmcnt(0)" ::: "memory"); __syncthreads();
        if (tid == 0 && (kq == 2 || kq == 3)) (void)xb_add(bw + XB_KVCNT + bb, 1u);
        grp_sync(bw + XCD_BAR_WORDS + 1024 + (8 * 64 + (c & 31)) * 4, bw, 8u);
        if (tid == 0) { XB_SPIN(xb_ld(bw + XB_KVCNT + bb) < 8u, bw); __builtin_amdgcn_fence(__ATOMIC_ACQUIRE, "agent"); asm volatile("s_waitcnt vmcnt(0)" ::: "memory"); }
        __syncthreads();
    }
    if (IN(10)) { for (int cc = c; cc < 256; cc += G) { const int t5 = cc & 31, it = (t5 >> 2) * 32 + (cc >> 5) * 4 + (t5 & 3);
            attn_item(lds, it, (const bf16_t*)(ws + WS_Q), (const bf16_t*)(ws + WS_K1), (const bf16_t*)(ws + WS_VT1), (const bf16_t*)(ws + WS_CK), (const bf16_t*)(ws + WS_CVT), P.in[18], R2, tid); } }
    if (IN(10) && IN(11)) grp_sync((unsigned*)(ws + WS_BAR) + XCD_BAR_WORDS + 1024 + (5 * 64 + (c & 31)) * 4, (unsigned*)(ws + WS_BAR), 8u);
    if (IN(11)) { SchedNat S{(const char*)R2, (const char*)(ws + WS_WO), D, 4, G, c};
        EpiResNorm<false> E{nullptr, nullptr, X, X, H, MOD + 9 * 6144 + 2 * 1024, P.in[9] + 1024, P.in[10] + 1024, MOD + 9 * 6144 + 3 * 1024, MOD + 9 * 6144 + 4 * 1024,
            (float*)(ws + WS_SLOTS) + 5 * 65536, (float*)(ws + WS_SLOTS) + 6 * 65536, (unsigned*)(ws + WS_BAR) + XCD_BAR_WORDS + 64 * 5, (unsigned*)(ws + WS_BAR) + XCD_BAR_WORDS + 64 * 6, (unsigned*)(ws + WS_BAR)};
        pg8::gemm_phase(lds, D, S, E); } GSEAM(11, 13, 2);
    if (IN(13)) { SchedNat S{(const char*)H, (const char*)(ws + WS_WGU + (size_t)5632 * D * 2), D, 22, G, c}; EpiSwiGLU E{HF}; pg8::gemm_phase(lds, D, S, E); } GSEAM(13, 14, 3);
    if (IN(14)) { SchedNat S{(const char*)HF, (const char*)(ws + WS_WDN + (size_t)1024 * DFF * 2), DFF, 4, G, c};
        EpiFinal E{X, P.out, MOD + 9 * 6144 + 5 * 1024, P.in[11] + 1024, (float*)(ws + WS_SLOTS), (unsigned*)(ws + WS_BAR) + XCD_BAR_WORDS, (unsigned*)(ws + WS_BAR)};
        pg8::gemm_phase(lds, DFF, S, E); }
#undef IN
#undef SEAM
}

extern "C" void kernel_launch(void* const* d_in, const int* in_sizes, int n_in, void* d_out, int out_size, void* d_ws, size_t ws_size, hipStream_t stream) {
    static int grid = 0;
    if (grid == 0) {
        if (n_in != 23 || ws_size < WS_END) { fprintf(stderr, "kernel_launch: unexpected inputs (n_in %d, ws %zu)\n", n_in, ws_size); grid = -1; return; }
        int dev = 0, cus = 0, per_cu = 0;
        hipGetDevice(&dev);
        hipDeviceGetAttribute(&cus, hipDeviceAttributeMultiprocessorCount, dev);
        if (hipFuncSetAttribute((const void*)fwd_kernel, hipFuncAttributeMaxDynamicSharedMemorySize, LDS_BYTES) != hipSuccess) { fprintf(stderr, "kernel_launch: hipFuncSetAttribute failed\n"); grid = -1; return; }
        hipOccupancyMaxActiveBlocksPerMultiprocessor(&per_cu, (const void*)fwd_kernel, 512, LDS_BYTES);
        (void)hipGetLastError();
        if (per_cu < 1) per_cu = 1;
        if (cus < 256) { fprintf(stderr, "kernel_launch: built for a 256-CU device (got %d CUs)\n", cus); grid = -1; return; }
        grid = 256;
        fprintf(stderr, "kernel_launch: cus %d per_cu %d grid %d\n", cus, per_cu, grid);
    }
    if (grid < 0) return;
    Params p{};
    for (int i = 0; i < 23; ++i) p.in[i] = (const float*)d_in[i];
    p.out = (float*)d_out; p.ws = (unsigned char*)d_ws;
#if MK_PER_PHASE
#ifndef HOST_REPEAT_MASK
#define HOST_REPEAT_MASK 0
#endif
    for (int ph = 0; ph < NPHASE; ++ph) for (int rep = 0; rep <= ((HOST_REPEAT_MASK >> ph) & 1); ++rep) { if (rep) (void)hipMemsetAsync((char*)d_ws + WS_STATS, 0, 4 * 16384 * 4, stream); p.ph_lo = ph; p.ph_hi = ph + 1; hipLaunchKernelGGL(fwd_kernel, dim3(grid), dim3(512), LDS_BYTES, stream, p); }
#else
    p.ph_lo = 0; p.ph_hi = NPHASE;
    if (hipMemsetAsync((char*)d_ws + WS_BAR, 0, (XCD_BAR_WORDS + 3328) * 4, stream) != hipSuccess) { fprintf(stderr, "kernel_launch: memset failed\n"); return; }
    void* args[] = {&p};
    hipError_t e = hipLaunchCooperativeKernel((const void*)fwd_kernel, dim3(grid), dim3(512), args, LDS_BYTES, stream);
    if (e != hipSuccess) fprintf(stderr, "cooperative launch failed: %s (grid %d)\n", hipGetErrorString(e), grid);
#endif
}
```
